# Optimizing an MI355X kernel written in HIP

```python
import math
import jax, jax.numpy as jnp
from jax import lax
import numpy as np

D_MODEL = 1024
BATCH = 32
SEQ = 2048
DEPTH = 1

D_MIX = D_MODEL
ATTN_HEADS = 8
ATTN_HD = 64
ATTN_W = ATTN_HEADS * ATTN_HD
MOBA_BLOCK = 256
MOBA_TOPK = 3
Q_BLOCK = 128
REC_HEADS = 4
REC_DK = 128
REC_DV = 128
REC_W = REC_HEADS * REC_DK
REC_VW = REC_HEADS * REC_DV
REC_CHUNK = 64
PEER_HEADS = 8
PEER_NKEYS = 128
PEER_N = PEER_NKEYS * PEER_NKEYS
PEER_DKEY = 256
PEER_TOPK = 16
PEER_TOKEN_BLOCK = 128
NORM_EPS = 1e-6
IN_WIDTHS = [ATTN_W, ATTN_W, ATTN_W, REC_W, REC_W, REC_VW, REC_VW]
IN_COLS = sum(IN_WIDTHS)
IN_SPLITS = [int(c) for c in np.cumsum(IN_WIDTHS)[:-1]]

kernel_name = 'hymba_moba_hgrn2_peer_block'


def rmsnorm(x, g):
    xf = x.astype(jnp.float32)
    y = xf * lax.rsqrt(jnp.mean(xf * xf, axis=-1, keepdims=True) + NORM_EPS)
    return (y * g.astype(jnp.float32)).astype(x.dtype)


def alibi_slopes(n):
    return 2.0 ** (-8.0 * jnp.arange(1, n + 1, dtype=jnp.float32) / n)


def moba_attention(q, k, v):
    B, S, H, hd = q.shape
    nb = -(-S // MOBA_BLOCK)
    pad = nb * MOBA_BLOCK - S
    kp = jnp.pad(k, ((0, 0), (0, pad), (0, 0), (0, 0)))
    vp = jnp.pad(v, ((0, 0), (0, pad), (0, 0), (0, 0)))
    kb = kp.reshape(B, nb, MOBA_BLOCK, H, hd).transpose(0, 3, 1, 2, 4)
    vb = vp.reshape(B, nb, MOBA_BLOCK, H, hd).transpose(0, 3, 1, 2, 4)
    kmean = jnp.mean(kb.astype(jnp.float32), axis=3)
    gate = jnp.einsum('bshd,bhnd->bhsn', q.astype(jnp.float32), kmean)
    pos = jnp.arange(S)
    past = jnp.arange(nb)[None, :] < (pos // MOBA_BLOCK)[:, None]
    gate = jnp.where(past[None, None], gate, -jnp.inf)
    ksel = min(MOBA_TOPK, nb)
    _, sel = lax.top_k(gate, ksel)
    nq = S // Q_BLOCK
    qq = q.reshape(B, nq, Q_BLOCK, H, hd).transpose(0, 1, 3, 2, 4).reshape(B * nq, H, Q_BLOCK, hd)
    ss = sel.reshape(B, H, nq, Q_BLOCK, ksel).transpose(0, 2, 1, 3, 4).reshape(B * nq, H, Q_BLOCK, ksel)
    b_idx = jnp.repeat(jnp.arange(B, dtype=jnp.int32), nq)
    qb_idx = jnp.tile(jnp.arange(nq, dtype=jnp.int32), B)
    slopes = alibi_slopes(H)
    scale = hd ** -0.5
    off = jnp.arange(MOBA_BLOCK)
    gather = jax.vmap(lambda kk, s: kk[s])

    def one_block(args):
        qblk, sblk, b, qi = args
        kh = kb[b]
        vh = vb[b]
        tpos = qi * Q_BLOCK + jnp.arange(Q_BLOCK)
        own = (qi * Q_BLOCK) // MOBA_BLOCK
        k_s = gather(kh, sblk).astype(jnp.float32)
        v_s = gather(vh, sblk).astype(jnp.float32)
        k_o = lax.dynamic_index_in_dim(kh, own, axis=1, keepdims=False).astype(jnp.float32)
        v_o = lax.dynamic_index_in_dim(vh, own, axis=1, keepdims=False).astype(jnp.float32)
        qf = qblk.astype(jnp.float32) * scale
        s_sel = jnp.einsum('hqd,hqjkd->hqjk', qf, k_s)
        kpos_sel = sblk[..., None] * MOBA_BLOCK + off
        dist_sel = (tpos[None, :, None, None] - kpos_sel).astype(jnp.float32)
        s_sel = s_sel - slopes[:, None, None, None] * dist_sel
        s_sel = jnp.where((sblk < own)[..., None], s_sel, -jnp.inf)
        s_own = jnp.einsum('hqd,hkd->hqk', qf, k_o)
        kpos_own = own * MOBA_BLOCK + off
        dist_own = (tpos[:, None] - kpos_own[None, :]).astype(jnp.float32)
        s_own = s_own - slopes[:, None, None] * dist_own[None]
        s_own = jnp.where((kpos_own[None, :] <= tpos[:, None])[None], s_own, -jnp.inf)
        logits = jnp.concatenate([s_sel.reshape(H, Q_BLOCK, ksel * MOBA_BLOCK), s_own], axis=-1)
        p = jax.nn.softmax(logits, axis=-1)
        p_sel = p[..., :ksel * MOBA_BLOCK].reshape(H, Q_BLOCK, ksel, MOBA_BLOCK)
        p_own = p[..., ksel * MOBA_BLOCK:]
        o = jnp.einsum('hqjk,hqjkd->qhd', p_sel, v_s) + jnp.einsum('hqk,hkd->qhd', p_own, v_o)
        return o.astype(q.dtype)

    out = lax.map(one_block, (qq, ss, b_idx, qb_idx))
    return out.reshape(B, S, H * hd)


def hgrn2(q, f_pre, i, g, lb, norm_g):
    B, S, _ = q.shape
    nc = S // REC_CHUNK
    f = lb + (1.0 - lb) * jax.nn.sigmoid(f_pre.astype(jnp.float32))
    logf = jnp.log(f)
    kk = 1.0 - f
    qf = jax.nn.silu(q.astype(jnp.float32))
    vf = i.astype(jnp.float32)

    def heads(t, d):
        return t.reshape(B, nc, REC_CHUNK, REC_HEADS, d).transpose(1, 0, 3, 2, 4)

    causal = jnp.tril(jnp.ones((REC_CHUNK, REC_CHUNK), dtype=bool))

    def step(state, inp):
        qc, lfc, kc, vc = inp
        cum = jnp.cumsum(lfc, axis=2)
        diff = cum[:, :, :, None, :] - cum[:, :, None, :, :]
        decay = jnp.where(causal[None, None, :, :, None], jnp.exp(jnp.minimum(diff, 0.0)), 0.0)
        scores = jnp.einsum('bhtd,bhtsd,bhsd->bhts', qc, decay, kc)
        o = jnp.einsum('bhts,bhsv->bhtv', scores, vc) + jnp.einsum('bhtd,bhdv->bhtv', qc * jnp.exp(cum), state)
        last = cum[:, :, -1:, :]
        state = jnp.exp(last[:, :, 0, :])[..., None] * state + jnp.einsum('bhsd,bhsv->bhdv', kc * jnp.exp(last - cum), vc)
        return state, o

    state0 = jnp.zeros((B, REC_HEADS, REC_DK, REC_DV), jnp.float32)
    _, o = lax.scan(step, state0, (heads(qf, REC_DK), heads(logf, REC_DK), heads(kk, REC_DK), heads(vf, REC_DV)))
    o = o.transpose(1, 0, 3, 2, 4).reshape(B, S, REC_HEADS, REC_DV)
    o = rmsnorm(o, norm_g.reshape(REC_HEADS, REC_DV))
    o = o * jax.nn.silu(g.astype(jnp.float32)).reshape(B, S, REC_HEADS, REC_DV)
    return o.reshape(B, S, REC_VW).astype(q.dtype)


def peer(x, wq, subkeys, u, v):
    B, S, D = x.shape
    T = B * S
    xt = x.reshape(T // PEER_TOKEN_BLOCK, PEER_TOKEN_BLOCK, D)

    def one(xb):
        qp = (xb @ wq).reshape(PEER_TOKEN_BLOCK, PEER_HEADS, 2, PEER_DKEY // 2)
        s = jnp.einsum('thcd,hcnd->thcn', qp.astype(jnp.float32), subkeys.astype(jnp.float32))
        v1, i1 = lax.top_k(s[:, :, 0], PEER_TOPK)
        v2, i2 = lax.top_k(s[:, :, 1], PEER_TOPK)
        cand = (v1[..., :, None] + v2[..., None, :]).reshape(PEER_TOKEN_BLOCK, PEER_HEADS, PEER_TOPK * PEER_TOPK)
        cidx = (i1[..., :, None] * PEER_NKEYS + i2[..., None, :]).reshape(PEER_TOKEN_BLOCK, PEER_HEADS, PEER_TOPK * PEER_TOPK)
        sc, p = lax.top_k(cand, PEER_TOPK)
        eidx = jnp.take_along_axis(cidx, p, axis=-1)
        gates = jax.nn.softmax(sc, axis=-1)
        ue = u[eidx]
        ve = v[eidx]
        act = jax.nn.gelu(jnp.einsum('td,thkd->thk', xb, ue).astype(jnp.float32), approximate=False)
        return jnp.einsum('thk,thkd->td', (gates * act).astype(x.dtype), ve)

    return lax.map(one, xt).reshape(B, S, D)


def setup_inputs(seed: int = 0) -> dict:
    key = jax.random.key(seed)
    ks = jax.random.split(key, 12)
    nrm = jax.random.normal
    x = nrm(ks[0], (BATCH, SEQ, D_MODEL), jnp.float32)
    norm1_g = 1.0 + 0.05 * nrm(ks[1], (DEPTH, D_MODEL), jnp.float32)
    w_in = nrm(ks[2], (DEPTH, D_MODEL, IN_COLS), jnp.float32) * D_MODEL ** -0.5
    rec_lb_logits = 0.5 * nrm(ks[3], (DEPTH + 1, REC_W), jnp.float32)
    rec_norm_g = 1.0 + 0.05 * nrm(ks[4], (DEPTH, REC_VW), jnp.float32)
    w_out = nrm(ks[5], (DEPTH, D_MIX, D_MODEL), jnp.float32) * D_MIX ** -0.5
    norm2_g = 1.0 + 0.05 * nrm(ks[6], (DEPTH, D_MODEL), jnp.float32)
    peer_wq = nrm(ks[7], (DEPTH, D_MODEL, PEER_HEADS * PEER_DKEY), jnp.float32) * D_MODEL ** -0.5
    peer_subkeys = nrm(ks[8], (DEPTH, PEER_HEADS, 2, PEER_NKEYS, PEER_DKEY // 2), jnp.float32) * (PEER_DKEY // 2) ** -0.5
    peer_u = nrm(ks[9], (DEPTH, PEER_N, D_MODEL), jnp.float32) * D_MODEL ** -0.5
    peer_v = 0.1 * nrm(ks[10], (DEPTH, PEER_N, D_MODEL), jnp.float32)
    normf_g = 1.0 + 0.05 * nrm(ks[11], (D_MODEL,), jnp.float32)
    return {'x': x, 'norm1_g': norm1_g, 'w_in': w_in, 'rec_lb_logits': rec_lb_logits,
            'rec_norm_g': rec_norm_g, 'w_out': w_out, 'norm2_g': norm2_g, 'peer_wq': peer_wq,
            'peer_subkeys': peer_subkeys, 'peer_u': peer_u, 'peer_v': peer_v, 'normf_g': normf_g}


def reference(x, norm1_g, w_in, rec_lb_logits, rec_norm_g, w_out, norm2_g, peer_wq, peer_subkeys, peer_u, peer_v, normf_g):
    B, S, _ = x.shape
    lb_all = jnp.cumsum(jax.nn.softmax(rec_lb_logits.astype(jnp.float32), axis=0), axis=0)
    h = x
    for layer in range(DEPTH):
        xn = rmsnorm(h, norm1_g[layer])
        proj = xn @ w_in[layer]
        q_a, k_a, v_a, q_r, f_r, i_r, g_r = jnp.split(proj, IN_SPLITS, axis=-1)
        attn = moba_attention(q_a.reshape(B, S, ATTN_HEADS, ATTN_HD),
                              k_a.reshape(B, S, ATTN_HEADS, ATTN_HD),
                              v_a.reshape(B, S, ATTN_HEADS, ATTN_HD))
        rec = hgrn2(q_r, f_r, i_r, g_r, lb_all[layer], rec_norm_g[layer])
        h = h + jnp.concatenate([attn, rec], axis=-1) @ w_out[layer]
        hn = rmsnorm(h, norm2_g[layer])
        h = h + peer(hn, peer_wq[layer], peer_subkeys[layer], peer_u[layer], peer_v[layer])
    return rmsnorm(h, normf_g)
```

```cpp
#include <hip/hip_runtime.h>
#include <stdint.h>
#include <math.h>

typedef _Float16 h16;
typedef _Float16 h16x8 __attribute__((ext_vector_type(8)));

constexpr int D = 1024, NB_ = 32, S = 2048, T = NB_ * S;
constexpr int INC = 3584;
constexpr int C_QA = 0, C_KA = 512, C_VA = 1024, C_QR = 1536, C_FR = 2048, C_IR = 2560, C_GR = 3072;
constexpr int AH = 8;
constexpr int RH = 4;
constexpr int PH = 8, PNK = 128, PK = 16, QW = 2048;
constexpr float EPS = 1e-6f;

constexpr size_t MiB = 1ull << 20;
constexpr size_t WS_LB = 64 * 1024;
constexpr size_t WS_WIN = 2 * MiB;
constexpr size_t WS_WOUT = 10 * MiB;
constexpr size_t WS_WQ = 12 * MiB;
constexpr size_t WS_SUBK = 16 * MiB;
constexpr size_t WS_KM = 17 * MiB;
constexpr size_t WS_U = 32 * MiB;
constexpr size_t WS_V = 64 * MiB;
constexpr size_t WS_XN = 96 * MiB;
constexpr size_t WS_PROJ = 224 * MiB;
constexpr size_t WS_QP = 224 * MiB;
constexpr size_t WS_HN = 480 * MiB;
constexpr size_t WS_SELI = 672 * MiB;
constexpr size_t WS_SELG = 704 * MiB;

struct P {
    const float *x, *g1, *w_in, *lb_logits, *rec_g, *w_out, *g2, *wq, *subk, *u, *v, *gf;
    float* out;
    unsigned char* ws;
};

__device__ __forceinline__ float wave_sum(float v) {
#pragma unroll
    for (int o = 1; o < 64; o <<= 1) v += __shfl_xor(v, o);
    return v;
}
__device__ __forceinline__ float wave_max(float v) {
#pragma unroll
    for (int o = 1; o < 64; o <<= 1) v = fmaxf(v, __shfl_xor(v, o));
    return v;
}
__device__ __forceinline__ float sigmoidf_(float x) { return 1.f / (1.f + __expf(-x)); }

__global__ void __launch_bounds__(256) k_prep_weights(P p) {
    h16* WinT = (h16*)(p.ws + WS_WIN); h16* WoutT = (h16*)(p.ws + WS_WOUT); h16* WqT = (h16*)(p.ws + WS_WQ);
    h16* SUBK = (h16*)(p.ws + WS_SUBK); h16* U = (h16*)(p.ws + WS_U); h16* V = (h16*)(p.ws + WS_V); float* LB = (float*)(p.ws + WS_LB);
    const size_t gid = (size_t)blockIdx.x * blockDim.x + threadIdx.x, gs = (size_t)gridDim.x * blockDim.x;
    for (size_t i = gid; i < (size_t)INC * D; i += gs) { const int n = (int)(i / D), k = (int)(i % D); WinT[i] = (h16)p.w_in[(size_t)k * INC + n]; }
    for (size_t i = gid; i < (size_t)D * D; i += gs) { const int n = (int)(i / D), k = (int)(i % D); WoutT[i] = (h16)p.w_out[(size_t)k * D + n]; }
    for (size_t i = gid; i < (size_t)QW * D; i += gs) { const int n = (int)(i / D), k = (int)(i % D); WqT[i] = (h16)p.wq[(size_t)k * QW + n]; }
    for (size_t i = gid; i < (size_t)PH * 2 * 128 * 128; i += gs) SUBK[i] = (h16)p.subk[i];
    for (size_t i = gid; i < (size_t)16384 * D; i += gs) { U[i] = (h16)p.u[i]; V[i] = (h16)p.v[i]; }
    for (size_t i = gid; i < 512; i += gs) { const float a = p.lb_logits[i], b = p.lb_logits[512 + i]; const float m = fmaxf(a, b); const float ea = __expf(a - m), eb = __expf(b - m); LB[i] = ea / (ea + eb); }
}

__global__ void __launch_bounds__(256) k_rmsnorm_rows(const float* X, const float* g, h16* O) {
    const int lane = threadIdx.x & 63; const int gw = (blockIdx.x * blockDim.x + threadIdx.x) >> 6, nw = (gridDim.x * blockDim.x) >> 6;
    for (int t = gw; t < T; t += nw) {
        const float4* xr = (const float4*)(X + (size_t)t * D);
        float4 v[4]; float s = 0.f;
#pragma unroll
        for (int j = 0; j < 4; ++j) { v[j] = xr[lane + 64 * j]; s += v[j].x * v[j].x + v[j].y * v[j].y + v[j].z * v[j].z + v[j].w * v[j].w; }
        const float r = rsqrtf(wave_sum(s) * (1.f / D) + EPS);
#pragma unroll
        for (int j = 0; j < 4; ++j) { const int c = (lane + 64 * j) * 4; const float4 gg = *(const float4*)(g + c);
            h16* o = O + (size_t)t * D + c; o[0] = (h16)(v[j].x * r * gg.x); o[1] = (h16)(v[j].y * r * gg.y); o[2] = (h16)(v[j].z * r * gg.z); o[3] = (h16)(v[j].w * r * gg.w); }
    }
}

struct EpiH16 { h16* O; int ld; int pad; __device__ void operator()(int r, int c, float v) const { O[(size_t)r * ld + c] = (h16)v; } };
struct EpiResF32 { const float* base; float* O; int ld; int pad; __device__ void operator()(int r, int c, float v) const { O[(size_t)r * ld + c] = base[(size_t)r * ld + c] + v; } };

template <class Epi> __global__ void __launch_bounds__(256) k_gemm_naive(const h16* A, const h16* Bt, int M, int N, int K, Epi epi) {
    __shared__ float As[16][68], Bs[16][68];
    const int tid = threadIdx.x, ty = tid >> 4, tx = tid & 15; const int ntn = N / 64, ntiles = (M / 64) * ntn;
    for (int tile = blockIdx.x; tile < ntiles; tile += gridDim.x) {
        const int tm = tile / ntn, tn = tile % ntn;
        float acc[4][4];
#pragma unroll
        for (int i = 0; i < 4; ++i)
#pragma unroll
            for (int j = 0; j < 4; ++j) acc[i][j] = 0.f;
        const int lr = tid >> 2, lk = (tid & 3) * 4;
        const h16* ap = A + (size_t)(tm * 64 + lr) * K + lk; const h16* bp = Bt + (size_t)(tn * 64 + lr) * K + lk;
        for (int k0 = 0; k0 < K; k0 += 16) {
#pragma unroll
            for (int i = 0; i < 4; ++i) { As[lk + i][lr] = (float)ap[k0 + i]; Bs[lk + i][lr] = (float)bp[k0 + i]; }
            __syncthreads();
#pragma unroll
            for (int k = 0; k < 16; ++k) { float a[4], b[4];
#pragma unroll
                for (int i = 0; i < 4; ++i) { a[i] = As[k][ty * 4 + i]; b[i] = Bs[k][tx * 4 + i]; }
#pragma unroll
                for (int i = 0; i < 4; ++i)
#pragma unroll
                    for (int j = 0; j < 4; ++j) acc[i][j] += a[i] * b[j]; }
            __syncthreads();
        }
#pragma unroll
        for (int i = 0; i < 4; ++i)
#pragma unroll
            for (int j = 0; j < 4; ++j) epi(tm * 64 + ty * 4 + i, tn * 64 + tx * 4 + j, acc[i][j]);
    }
}

__global__ void __launch_bounds__(256) k_kmean(const h16* PROJ, float* KM) {
    for (int item = blockIdx.x; item < NB_ * 8 * 2; item += gridDim.x) {
        const int cg = item & 1, bj = item >> 1; const int c = cg * 256 + threadIdx.x;
        const h16* p = PROJ + (size_t)bj * 256 * INC + C_KA + c; float s = 0.f;
        for (int r = 0; r < 256; ++r) s += (float)p[(size_t)r * INC];
        KM[(size_t)bj * 512 + c] = s * (1.f / 256.f);
    }
}

__global__ void __launch_bounds__(256) k_attn_naive(const h16* PROJ, const float* KM, h16* MIX) {
    __shared__ float sl[4][1024]; __shared__ float sqd[4][64];
    const int lane = threadIdx.x & 63, w = threadIdx.x >> 6;
    for (int item = blockIdx.x * 4 + w; item < NB_ * AH * S; item += gridDim.x * 4) {
        const int pos = item % S, bh = item / S, h = bh % AH, b = bh / AH; const int own = pos >> 8;
        const float slope = exp2f(-(float)(h + 1));
        const float qd = (float)PROJ[(size_t)(b * S + pos) * INC + C_QA + h * 64 + lane];
        float gate[8];
#pragma unroll
        for (int j = 0; j < 8; ++j) { float g = (j < own) ? qd * KM[(size_t)(b * 8 + j) * 512 + h * 64 + lane] : 0.f; g = wave_sum(g); gate[j] = (j < own) ? g : -INFINITY; }
        unsigned sel = 0;
#pragma unroll
        for (int r = 0; r < 3; ++r) { float best = -INFINITY; int bi = -1;
#pragma unroll
            for (int j = 0; j < 8; ++j) if (!((sel >> j) & 1) && gate[j] > best) { best = gate[j]; bi = j; }
            if (bi >= 0) sel |= 1u << bi; }
        sel |= 1u << own;
        sqd[w][lane] = qd;
        float m = -INFINITY; int si = 0;
        for (int j = 0; j <= own; ++j) { if (!((sel >> j) & 1)) continue;
            for (int c4 = 0; c4 < 4; ++c4) { const int key = j * 256 + c4 * 64 + lane; const int keyc = key <= pos ? key : pos;
                const h16x8* kr = (const h16x8*)(PROJ + (size_t)(b * S + keyc) * INC + C_KA + h * 64); float a = 0.f;
#pragma unroll
                for (int d8 = 0; d8 < 8; ++d8) { const h16x8 kv = kr[d8];
#pragma unroll
                    for (int e = 0; e < 8; ++e) a += sqd[w][d8 * 8 + e] * (float)kv[e]; }
                const float s = (key <= pos) ? a * 0.125f - slope * (float)(pos - key) : -INFINITY;
                sl[w][si * 256 + c4 * 64 + lane] = s; m = fmaxf(m, s); }
            ++si; }
        m = wave_max(m);
        const int nk = si * 256; float l = 0.f;
        for (int i = lane; i < nk; i += 64) { const float pp = __expf(sl[w][i] - m); sl[w][i] = pp; l += pp; }
        l = wave_sum(l);
        float o = 0.f; si = 0;
        for (int j = 0; j <= own; ++j) { if (!((sel >> j) & 1)) continue;
            const int kend = (j == own) ? (pos - own * 256 + 1) : 256;
            const h16* vp = PROJ + (size_t)(b * S + j * 256) * INC + C_VA + h * 64 + lane;
            for (int kk = 0; kk < kend; ++kk) o += sl[w][si * 256 + kk] * (float)vp[(size_t)kk * INC];
            ++si; }
        MIX[(size_t)(b * S + pos) * D + h * 64 + lane] = (h16)(o / l);
    }
}

__global__ void __launch_bounds__(128) k_hgrn_naive(const h16* PROJ, const float* LB, const float* norm_g, h16* MIX) {
    __shared__ float sf[128], sk[128], sq[128], red[2];
    const int v = threadIdx.x, lane = v & 63, wv = v >> 6;
    for (int item = blockIdx.x; item < NB_ * RH; item += gridDim.x) {
        const int b = item / RH, hd = item % RH;
        float st[128];
#pragma unroll
        for (int d = 0; d < 128; ++d) st[d] = 0.f;
        const float lbv = LB[hd * 128 + v], ng = norm_g[hd * 128 + v];
        for (int t = 0; t < S; ++t) {
            const h16* row = PROJ + (size_t)(b * S + t) * INC;
            const float qv = (float)row[C_QR + hd * 128 + v], fp = (float)row[C_FR + hd * 128 + v];
            const float f = lbv + (1.f - lbv) * sigmoidf_(fp);
            sf[v] = f; sk[v] = 1.f - f; sq[v] = qv * sigmoidf_(qv);
            __syncthreads();
            const float vi = (float)row[C_IR + hd * 128 + v]; float o = 0.f;
#pragma unroll
            for (int d = 0; d < 128; ++d) { st[d] = sf[d] * st[d] + sk[d] * vi; o += sq[d] * st[d]; }
            const float ss = wave_sum(o * o); if (lane == 0) red[wv] = ss;
            __syncthreads();
            const float tot = red[0] + red[1];
            const float g = (float)row[C_GR + hd * 128 + v];
            const float y = o * rsqrtf(tot * (1.f / 128.f) + EPS) * ng * (g * sigmoidf_(g));
            MIX[(size_t)(b * S + t) * D + 512 + hd * 128 + v] = (h16)y;
            __syncthreads();
        }
    }
}

__device__ __forceinline__ void top_insert(float (&v)[16], int (&ix)[16], float x, int id) {
    if (x > v[15]) { v[15] = x; ix[15] = id;
#pragma unroll
        for (int j = 15; j > 0; --j) { const bool sw = v[j] > v[j - 1]; const float a = v[j], bb = v[j - 1]; const int ia = ix[j], ib = ix[j - 1];
            v[j] = sw ? bb : a; v[j - 1] = sw ? a : bb; ix[j] = sw ? ib : ia; ix[j - 1] = sw ? ia : ib; } }
}
__global__ void __launch_bounds__(256) k_peer_topk_naive(const h16* QP, const h16* SUBK, int* SELI, float* SELG) {
    __shared__ float cv[32][256]; __shared__ unsigned char ci[32][256];
    const int tid = threadIdx.x;
    for (int item = blockIdx.x; item < (T / 256) * PH; item += gridDim.x) {
        const int h = item % PH, t = (item / PH) * 256 + tid;
        for (int c = 0; c < 2; ++c) {
            float qv[128];
            const h16x8* qr = (const h16x8*)(QP + (size_t)t * QW + h * 256 + c * 128);
#pragma unroll
            for (int d8 = 0; d8 < 16; ++d8) { const h16x8 q8 = qr[d8];
#pragma unroll
                for (int e = 0; e < 8; ++e) qv[d8 * 8 + e] = (float)q8[e]; }
            float tv[16]; int ti[16];
#pragma unroll
            for (int k = 0; k < 16; ++k) { tv[k] = -INFINITY; ti[k] = 0; }
            for (int n = 0; n < 128; ++n) { const h16* sk = SUBK + (size_t)((h * 2 + c) * 128 + n) * 128; float s = 0.f;
#pragma unroll
                for (int d = 0; d < 128; ++d) s += qv[d] * (float)sk[d];
                top_insert(tv, ti, s, n); }
#pragma unroll
            for (int k = 0; k < 16; ++k) { cv[c * 16 + k][tid] = tv[k]; ci[c * 16 + k][tid] = (unsigned char)ti[k]; }
        }
        float sv[16]; int si[16];
#pragma unroll
        for (int k = 0; k < 16; ++k) { sv[k] = -INFINITY; si[k] = 0; }
        for (int a = 0; a < 16; ++a) { const float va = cv[a][tid]; const int ia = (int)ci[a][tid];
            for (int bb = 0; bb < 16; ++bb) top_insert(sv, si, va + cv[16 + bb][tid], ia * 128 + (int)ci[16 + bb][tid]); }
        float e[16], sum = 0.f;
#pragma unroll
        for (int k = 0; k < 16; ++k) { e[k] = __expf(sv[k] - sv[0]); sum += e[k]; }
        const float inv = 1.f / sum;
#pragma unroll
        for (int k = 0; k < 16; ++k) { SELI[((size_t)t * PH + h) * 16 + k] = si[k]; SELG[((size_t)t * PH + h) * 16 + k] = e[k] * inv; }
        __syncthreads();
    }
}

__global__ void __launch_bounds__(256) k_peer_gather_naive(const h16* HN, const h16* U, const h16* V, const int* SELI, const float* SELG, float* H, const float* gf) {
    const int lane = threadIdx.x & 63; const int gw = (blockIdx.x * blockDim.x + threadIdx.x) >> 6, nw = (gridDim.x * blockDim.x) >> 6;
    for (int t = gw; t < T; t += nw) {
        float x[16], acc[16];
        { const h16x8* hr = (const h16x8*)(HN + (size_t)t * D + lane * 16); const h16x8 a = hr[0], b = hr[1];
#pragma unroll
          for (int i = 0; i < 8; ++i) { x[i] = (float)a[i]; x[8 + i] = (float)b[i]; acc[i] = 0.f; acc[8 + i] = 0.f; } }
        for (int j = 0; j < 128; ++j) {
            const int e = SELI[(size_t)t * 128 + j]; const float g = SELG[(size_t)t * 128 + j];
            const h16x8* ur = (const h16x8*)(U + (size_t)e * D + lane * 16); const h16x8 ua = ur[0], ub = ur[1];
            float dp = 0.f;
#pragma unroll
            for (int i = 0; i < 8; ++i) dp += x[i] * (float)ua[i] + x[8 + i] * (float)ub[i];
            dp = wave_sum(dp);
            const float act = 0.5f * dp * (1.f + erff(dp * 0.70710678118654752f));
            const float wgt = g * act;
            const h16x8* vr = (const h16x8*)(V + (size_t)e * D + lane * 16); const h16x8 va = vr[0], vb = vr[1];
#pragma unroll
            for (int i = 0; i < 8; ++i) { acc[i] += wgt * (float)va[i]; acc[8 + i] += wgt * (float)vb[i]; }
        }
        float* hr = H + (size_t)t * D + lane * 16; float o[16]; float ss = 0.f;
#pragma unroll
        for (int i = 0; i < 4; ++i) { const float4 hv = ((const float4*)hr)[i]; o[4 * i] = hv.x + acc[4 * i]; o[4 * i + 1] = hv.y + acc[4 * i + 1]; o[4 * i + 2] = hv.z + acc[4 * i + 2]; o[4 * i + 3] = hv.w + acc[4 * i + 3]; }
#pragma unroll
        for (int i = 0; i < 16; ++i) ss += o[i] * o[i];
        const float r = rsqrtf(wave_sum(ss) * (1.f / D) + EPS);
#pragma unroll
        for (int i = 0; i < 4; ++i) { const float4 gg = *(const float4*)(gf + lane * 16 + 4 * i);
            ((float4*)hr)[i] = make_float4(o[4 * i] * r * gg.x, o[4 * i + 1] * r * gg.y, o[4 * i + 2] * r * gg.z, o[4 * i + 3] * r * gg.w); }
    }
}

extern "C" void kernel_launch(void* const* d_in, const int* in_sizes, int n_in, void* d_out, int out_size, void* d_ws, size_t ws_size, hipStream_t stream) {
    P p{};
    p.x = (const float*)d_in[0]; p.g1 = (const float*)d_in[1]; p.w_in = (const float*)d_in[2]; p.lb_logits = (const float*)d_in[3]; p.rec_g = (const float*)d_in[4];
    p.w_out = (const float*)d_in[5]; p.g2 = (const float*)d_in[6]; p.wq = (const float*)d_in[7]; p.subk = (const float*)d_in[8]; p.u = (const float*)d_in[9];
    p.v = (const float*)d_in[10]; p.gf = (const float*)d_in[11]; p.out = (float*)d_out; p.ws = (unsigned char*)d_ws;
    unsigned char* ws = p.ws;
    h16* WinT = (h16*)(ws + WS_WIN); h16* WoutT = (h16*)(ws + WS_WOUT); h16* WqT = (h16*)(ws + WS_WQ); h16* SUBK = (h16*)(ws + WS_SUBK);
    h16* U = (h16*)(ws + WS_U); h16* V = (h16*)(ws + WS_V); float* LB = (float*)(ws + WS_LB); float* KM = (float*)(ws + WS_KM);
    h16* XN = (h16*)(ws + WS_XN); h16* MIX = XN; h16* PROJ = (h16*)(ws + WS_PROJ); h16* QP = (h16*)(ws + WS_QP); h16* HN = (h16*)(ws + WS_HN);
    int* SELI = (int*)(ws + WS_SELI); float* SELG = (float*)(ws + WS_SELG);
    const int G = 2048;
    k_prep_weights<<<G, 256, 0, stream>>>(p);
    k_rmsnorm_rows<<<G, 256, 0, stream>>>(p.x, p.g1, XN);
    k_gemm_naive<EpiH16><<<4096, 256, 0, stream>>>(XN, WinT, T, INC, D, EpiH16{PROJ, INC, 0});
    k_kmean<<<512, 256, 0, stream>>>(PROJ, KM);
    k_attn_naive<<<4096, 256, 0, stream>>>(PROJ, KM, MIX);
    k_hgrn_naive<<<128, 128, 0, stream>>>(PROJ, LB, p.rec_g, MIX);
    k_gemm_naive<EpiResF32><<<4096, 256, 0, stream>>>(MIX, WoutT, T, D, D, EpiResF32{p.x, p.out, D, 0});
    k_rmsnorm_rows<<<G, 256, 0, stream>>>(p.out, p.g2, HN);
    k_gemm_naive<EpiH16><<<4096, 256, 0, stream>>>(HN, WqT, T, QW, D, EpiH16{QP, QW, 0});
    k_peer_topk_naive<<<2048, 256, 0, stream>>>(QP, SUBK, SELI, SELG);
    k_peer_gather_naive<<<G, 256, 0, stream>>>(HN, U, V, SELI, SELG, p.out, p.gf);
}
```

```cpp
#include <hip/hip_runtime.h>
#include <hip/hip_cooperative_groups.h>
#include <cstdio>
#include <stdint.h>
#include <math.h>
namespace cg = cooperative_groups;

typedef _Float16 h16;
typedef _Float16 h16x8 __attribute__((ext_vector_type(8)));
typedef _Float16 h16x2 __attribute__((ext_vector_type(2)));
typedef float f32x2 __attribute__((ext_vector_type(2)));
typedef float f32x16 __attribute__((ext_vector_type(16)));

constexpr int D = 1024, NB_ = 32, S = 2048, T = NB_ * S;
constexpr int INC = 3584;
constexpr int C_QA = 0, C_KA = 512, C_VA = 1024, C_QR = 1536, C_FR = 2048, C_IR = 2560, C_GR = 3072;
constexpr int AH = 8;
constexpr int RH = 4;
constexpr int PH = 8, QW = 2048;
constexpr float EPS = 1e-6f;
constexpr int NTHR = 512, NWAVE = 8;

constexpr size_t MiB = 1ull << 20;
constexpr size_t WS_LB = 64 * 1024;
constexpr size_t WS_WIN = 2 * MiB;
constexpr size_t WS_WOUT = 10 * MiB;
constexpr size_t WS_WQ = 12 * MiB;
constexpr size_t WS_KM = 17 * MiB;
constexpr size_t WS_SS = 18 * MiB;
constexpr size_t WS_U = 32 * MiB;
constexpr size_t WS_V = 64 * MiB;
constexpr size_t WS_XN = 96 * MiB;
constexpr size_t WS_PROJ = 224 * MiB;
constexpr size_t WS_QP = 224 * MiB;
constexpr size_t WS_HN = 480 * MiB;
constexpr size_t WS_SELI = 672 * MiB;
constexpr size_t WS_H16 = 800 * MiB;
constexpr size_t WS_HN8 = 704 * MiB;

struct P {
    const float *x, *g1, *w_in, *lb_logits, *rec_g, *w_out, *g2, *wq, *subk, *u, *v, *gf;
    float* out;
    unsigned char* ws;
};

#define LAS __attribute__((address_space(3)))
__device__ __forceinline__ int otid() { int t = threadIdx.x; asm volatile("" : "+v"(t)); return t; }
__device__ __forceinline__ float wave_sum(float v) {
#pragma unroll
    for (int o = 1; o < 64; o <<= 1) v += __shfl_xor(v, o);
    return v;
}
__device__ __forceinline__ float wave_max(float v) {
#pragma unroll
    for (int o = 1; o < 64; o <<= 1) v = fmaxf(v, __shfl_xor(v, o));
    return v;
}
__device__ __forceinline__ float sigmoidf_(float x) { return __builtin_amdgcn_rcpf(1.f + __builtin_amdgcn_exp2f(x * -1.4426950408889634f)); }
__device__ __forceinline__ unsigned q8(float v) { const float r = fminf(fmaxf(rintf(v), -127.f), 127.f); return (unsigned)((int)r) & 0xffu; }
typedef __bf16 bf16x2v __attribute__((ext_vector_type(2)));
__device__ __forceinline__ unsigned pkb(float lo, float hi) { f32x2 v = {lo, hi}; bf16x2v h = __builtin_convertvector(v, bf16x2v); return __builtin_bit_cast(unsigned, h); }
__device__ __forceinline__ unsigned pkh(float lo, float hi) { f32x2 v = {lo, hi}; h16x2 h = __builtin_convertvector(v, h16x2); return __builtin_bit_cast(unsigned, h); }

namespace pg8 {
#define PG8_LAS __attribute__((address_space(3)))
typedef unsigned short bf16_t;
typedef _Float16 f16x8 __attribute__((ext_vector_type(8)));
typedef __bf16 bf16x8m __attribute__((ext_vector_type(8)));
typedef float f32x4 __attribute__((ext_vector_type(4)));
typedef unsigned u32x4 __attribute__((ext_vector_type(4)));
constexpr int BM = 256, BK = 64, HALF = 128, HTB = HALF * BK * 2  , STAGE_BYTES = 8 * HTB, NXCD = 8, WGM = 8;

__host__ __device__ __forceinline__ int lds_byte(int r, int c) { const int st = (r >> 4) * 2 + (c >> 5), rr = r & 15, cc = c & 31, ob = rr * 64 + cc * 2; return st * 1024 + (ob ^ (((ob >> 9) & 1) << 5)); }
__host__ __device__ __forceinline__ void stage_rc(int b, int& R, int& C) { const int st = b / 1024, sb = b % 1024, swz = sb ^ (((sb >> 9) & 1) << 5); R = (st >> 1) * 16 + swz / 64; C = (st & 1) * 32 + (swz % 64) / 2; }
__host__ __device__ __forceinline__ int perm32(int rho) { const int n = rho >> 4, i = rho & 15; return 8 * (i >> 2) + 4 * n + (i & 3); }

struct Unit { int pm, pn; };
struct Gemm { const bf16_t* A; const bf16_t* Bt; int M, N, K; };

struct StaticOrder {
    int nM, nN, nwg, G, c;
    __host__ __device__ void init(int M, int N, int G_, int c_) { nM = M / BM; nN = N / BM; nwg = nM * nN; G = G_; c = c_; }
    __host__ __device__ bool next(int i, Unit& u) const {
        const long L = (long)i * G + c; if (L >= nwg) return false;
        int wgid = (int)L; { const int q = nwg / NXCD, r = nwg % NXCD, xcd = wgid % NXCD, off = wgid / NXCD; wgid = (xcd < r ? xcd * (q + 1) : r * (q + 1) + (xcd - r) * q) + off; }
        const int nig = WGM * nN, gid = wgid / nig, fm = gid * WGM, gsz = (nM - fm) < WGM ? (nM - fm) : WGM;
        u.pm = fm + ((wgid % nig) % gsz); u.pn = (wgid % nig) / gsz; return true;
    }
    __device__ __forceinline__ void a_ready(const Unit&) const {}
    __device__ __forceinline__ void done(const Unit&) const {}
};

__device__ __forceinline__ void fl_xchg(u32x4& x0, u32x4& x1) {
    u32x4 a, b;
#pragma unroll
    for (int i = 0; i < 4; ++i) { unsigned p0 = x0[i], p1 = x1[i];
        a[i] = (unsigned)__builtin_amdgcn_update_dpp((int)p0, (int)p1, 0x128, 0xf, 0xc, false);
        b[i] = (unsigned)__builtin_amdgcn_update_dpp((int)p1, (int)p0, 0x128, 0xf, 0x3, false); }
    x0 = a; x1 = b;
}
struct EpiProj {
    static constexpr bool PERM = true, AFTER_DRAIN = false, ADJ = true;
    bf16_t* O; int ldc; float* KM;
    __device__ __forceinline__ void operator()(const f32x4 (&acc)[2][2][4][2], const Unit& u, int wr, int wc, int fr, int fq) const {
        const int row0 = u.pm * BM + wr * 64 + fr; const int colp = u.pn * BM + wc * 64 + fq * 8;
#pragma unroll
        for (int ai = 0; ai < 2; ++ai)
#pragma unroll
            for (int m = 0; m < 4; ++m) { bf16_t* rowp = O + (size_t)(row0 + ai * HALF + m * 16) * ldc + colp;
                u32x4 w[2];
#pragma unroll
                for (int bj = 0; bj < 2; ++bj) { const f32x4 v0 = acc[ai][bj][m][0], v1 = acc[ai][bj][m][1];
                    w[bj].x = pkh(v0[0], v0[1]); w[bj].y = pkh(v0[2], v0[3]); w[bj].z = pkh(v1[0], v1[1]); w[bj].w = pkh(v1[2], v1[3]); }
                __builtin_nontemporal_store(w[0], (u32x4*)(rowp)); __builtin_nontemporal_store(w[1], (u32x4*)(rowp + 32)); }
        if (u.pn == 2 || u.pn == 3) { const int col0 = u.pn * BM + wc * 64 + 8 * fq;
#pragma unroll
            for (int bj = 0; bj < 2; ++bj)
#pragma unroll
                for (int n = 0; n < 2; ++n)
#pragma unroll
                    for (int e = 0; e < 4; ++e) { float s = 0.f;
#pragma unroll
                        for (int ai = 0; ai < 2; ++ai)
#pragma unroll
                            for (int m = 0; m < 4; ++m) s += acc[ai][bj][m][n][e];
                        s += __builtin_bit_cast(float, __builtin_amdgcn_mov_dpp(__builtin_bit_cast(int, s), 0xB1, 0xf, 0xf, true));
                        s += __builtin_bit_cast(float, __builtin_amdgcn_mov_dpp(__builtin_bit_cast(int, s), 0x4E, 0xf, 0xf, true));
                        s += __builtin_bit_cast(float, __builtin_amdgcn_mov_dpp(__builtin_bit_cast(int, s), 0x141, 0xf, 0xf, true));
                        s += __builtin_bit_cast(float, __builtin_amdgcn_mov_dpp(__builtin_bit_cast(int, s), 0x140, 0xf, 0xf, true));
                        if (fr == 0) atomicAdd(KM + (size_t)u.pm * 512 + (col0 - 512) + bj * 32 + n * 4 + e, s); }
        }
    }
};
struct EpiOut {
    static constexpr bool PERM = true, AFTER_DRAIN = false, ADJ = false;
    const float* base; bf16_t* H16; int ldc; const float* g2; bf16_t* HN; unsigned char* HN8; float* SS;
    __device__ __forceinline__ void operator()(const f32x4 (&acc)[2][2][4][2], const Unit& u, int wr, int wc, int fr, int fq) const {
        const int row0 = u.pm * BM + wr * 64 + fr; const int col0 = u.pn * BM + wc * 32 + 8 * fq;
        f32x4 gv[2][2];
#pragma unroll
        for (int bj = 0; bj < 2; ++bj) { gv[bj][0] = *(const f32x4*)(g2 + col0 + bj * HALF); gv[bj][1] = *(const f32x4*)(g2 + col0 + bj * HALF + 4); }
#pragma unroll
        for (int ai = 0; ai < 2; ++ai)
#pragma unroll
            for (int m = 0; m < 4; ++m) { const int row = row0 + ai * HALF + m * 16; const size_t off = (size_t)row * ldc + col0; float ss = 0.f;
#pragma unroll
                for (int bj = 0; bj < 2; ++bj) {
                    const f32x4 h0 = *(const f32x4*)(base + off + bj * HALF) + acc[ai][bj][m][0], h1 = *(const f32x4*)(base + off + bj * HALF + 4) + acc[ai][bj][m][1];
                    { u32x4 hw; hw.x = pkh(h0[0], h0[1]); hw.y = pkh(h0[2], h0[3]); hw.z = pkh(h1[0], h1[1]); hw.w = pkh(h1[2], h1[3]); *(u32x4*)(H16 + off + bj * HALF) = hw; }
                    ss += (h0[0] * h0[0] + h0[1] * h0[1]) + (h0[2] * h0[2] + h0[3] * h0[3]) + (h1[0] * h1[0] + h1[1] * h1[1]) + (h1[2] * h1[2] + h1[3] * h1[3]);
                    const f32x4 a = h0 * gv[bj][0], c = h1 * gv[bj][1];
                    u32x4 w; w.x = pkh(a[0], a[1]); w.y = pkh(a[2], a[3]); w.z = pkh(c[0], c[1]); w.w = pkh(c[2], c[3]);
                    *(u32x4*)(HN + off + bj * HALF) = w;
                    uint2 q; q.x = q8(a[0] * 12.f) | (q8(a[1] * 12.f) << 8) | (q8(a[2] * 12.f) << 16) | (q8(a[3] * 12.f) << 24); q.y = q8(c[0] * 12.f) | (q8(c[1] * 12.f) << 8) | (q8(c[2] * 12.f) << 16) | (q8(c[3] * 12.f) << 24);
                    *(uint2*)(HN8 + off + bj * HALF) = q; }
                ss += __shfl_xor(ss, 16); ss += __shfl_xor(ss, 32);
                if (fq == 0) atomicAdd(SS + row, ss); }
    }
};
struct EpiH16RS {
    static constexpr bool PERM = true, AFTER_DRAIN = false, ADJ = true;
    bf16_t* O; int ldc; const float* SS;
    __device__ __forceinline__ void operator()(const f32x4 (&acc)[2][2][4][2], const Unit& u, int wr, int wc, int fr, int fq) const {
        const int row0 = u.pm * BM + wr * 64; const int colp = u.pn * BM + wc * 64 + fq * 8;
#pragma unroll
        for (int ai = 0; ai < 2; ++ai)
#pragma unroll
            for (int m = 0; m < 4; ++m) { const int rb = row0 + ai * HALF + m * 16; bf16_t* rowp = O + (size_t)(rb + fr) * ldc + colp;
                const float r = __builtin_amdgcn_rsqf(SS[rb + fr] * (1.f / 1024.f) + 1e-6f);
                u32x4 w[2];
#pragma unroll
                for (int bj = 0; bj < 2; ++bj) { const f32x4 v0 = acc[ai][bj][m][0] * r, v1 = acc[ai][bj][m][1] * r;
                    w[bj].x = pkh(v0[0], v0[1]); w[bj].y = pkh(v0[2], v0[3]); w[bj].z = pkh(v1[0], v1[1]); w[bj].w = pkh(v1[2], v1[3]); }
                __builtin_nontemporal_store(w[0], (u32x4*)(rowp)); __builtin_nontemporal_store(w[1], (u32x4*)(rowp + 32)); }
    }
};
template <class Epi, class Sched, bool ALIGN_EPI = false, bool SP2 = false, bool BF16 = false>
__device__ __forceinline__ void gemm_phase(PG8_LAS unsigned char* lds, const Gemm g, const Sched& S, const Epi& E) {
    const int tid = otid(), wid = __builtin_amdgcn_readfirstlane(tid >> 6), lane = tid & 63, wr = wid >> 2, wc = wid & 3, fr = lane & 15, fq = lane >> 4;
    const int K = g.K, nt = K / BK;
    unsigned voffA[2], voffB[2];
#pragma unroll
    for (int i = 0; i < 2; ++i) { int R, C; stage_rc(tid * 16 + i * 8192, R, C); const int Rb = Epi::ADJ ? ((R >> 5) * 64 + perm32(R & 31)) : Epi::PERM ? ((R & ~31) + perm32(R & 31)) : R;
        voffA[i] = (unsigned)(R * K + C) * 2u; voffB[i] = (unsigned)(Rb * K + C) * 2u; }
    const size_t kstep = (size_t)(BK * 2);
    const size_t hstep = (size_t)HALF * K * 2;
    const size_t tstep = 2 * hstep;
    const size_t hstepB = Epi::ADJ ? (size_t)32 * K * 2 : hstep;
    const unsigned ldsw = (unsigned)wid * 1024u;
    const int aoff = lds_byte(wr * 64 + fr, fq * 8), boff = lds_byte(wc * 32 + fr, fq * 8);
#define PG8_SA(b, h) (((b) * 2 + (h)) * HTB)
#define PG8_SB(b, h) ((4 + (b) * 2 + (h)) * HTB)
#define PG8_STAGE(bufoff, gbase, voff) do { _Pragma("unroll") for (int _i = 0; _i < 2; ++_i) \
        __builtin_amdgcn_global_load_lds((const unsigned*)((const char*)(gbase) + (voff)[_i]), (PG8_LAS unsigned*)(lds + (bufoff) + ldsw + _i * 8192), 16, 0, 0); } while (0)
#define PG8_LDA(dst, b, h) do { _Pragma("unroll") for (int m = 0; m < 4; ++m) _Pragma("unroll") for (int k = 0; k < 2; ++k) dst[m][k] = *(const PG8_LAS f16x8*)(lds + PG8_SA(b, h) + aoff + m * 2048 + k * 1024); } while (0)
#define PG8_LDB(dst, b, h) do { _Pragma("unroll") for (int n = 0; n < 2; ++n) _Pragma("unroll") for (int k = 0; k < 2; ++k) dst[n][k] = *(const PG8_LAS f16x8*)(lds + PG8_SB(b, h) + boff + n * 2048 + k * 1024); } while (0)
#define PG8_MMA(ai, bj, At, Bt) do { __builtin_amdgcn_s_setprio(1); _Pragma("unroll") for (int m = 0; m < 4; ++m) _Pragma("unroll") for (int n = 0; n < 2; ++n) _Pragma("unroll") for (int k = 0; k < 2; ++k) \
        acc[ai][bj][m][n] = BF16 ? __builtin_amdgcn_mfma_f32_16x16x32_bf16(__builtin_bit_cast(bf16x8m, Bt[n][k]), __builtin_bit_cast(bf16x8m, At[m][k]), acc[ai][bj][m][n], 0, 0, 0) : __builtin_amdgcn_mfma_f32_16x16x32_f16(Bt[n][k], At[m][k], acc[ai][bj][m][n], 0, 0, 0); __builtin_amdgcn_s_setprio(0); } while (0)
#define PG8_WAIT_V(n) asm volatile("s_waitcnt vmcnt(" #n ")" ::: "memory")
#define PG8_WAIT_L(n) asm volatile("s_waitcnt lgkmcnt(" #n ")" ::: "memory")
#define PG8_BAR __builtin_amdgcn_s_barrier()
#define PG8_SCHED __builtin_amdgcn_sched_barrier(0)
    Unit cur, nxt; int ui = 0;
    if (!S.next(0, cur)) return;
    f32x4 acc[2][2][4][2];
#pragma unroll
    for (int a = 0; a < 2; ++a)
#pragma unroll
        for (int b = 0; b < 2; ++b)
#pragma unroll
            for (int m = 0; m < 4; ++m)
#pragma unroll
                for (int n = 0; n < 2; ++n) acc[a][b][m][n] = (f32x4){0.f, 0.f, 0.f, 0.f};
    f16x8 At[4][2], B0[2][2], B1[2][2];
    const char* cA = (const char*)g.A + (size_t)cur.pm * tstep; const char* cB = (const char*)g.Bt + (size_t)cur.pn * tstep;
    S.a_ready(cur);
    if constexpr (SP2) {
        PG8_STAGE(PG8_SB(0, 0), cB, voffB); PG8_STAGE(PG8_SB(0, 1), cB + hstepB, voffB); PG8_STAGE(PG8_SA(0, 0), cA, voffA); PG8_STAGE(PG8_SA(0, 1), cA + hstep, voffA);
        if (wr == 1) PG8_BAR;
        PG8_WAIT_V(2); PG8_BAR;
        PG8_STAGE(PG8_SB(1, 0), cB + kstep, voffB); PG8_STAGE(PG8_SA(1, 0), cA + kstep, voffA); PG8_STAGE(PG8_SB(1, 1), cB + hstepB + kstep, voffB);
        PG8_WAIT_V(6); PG8_BAR;
    } else {
        PG8_STAGE(PG8_SB(0, 0), cB, voffB); PG8_STAGE(PG8_SA(0, 0), cA, voffA); PG8_STAGE(PG8_SB(0, 1), cB + hstepB, voffB); PG8_STAGE(PG8_SA(0, 1), cA + hstep, voffA);
        if (wr == 1) PG8_BAR;
        PG8_WAIT_V(4); PG8_BAR;
        PG8_STAGE(PG8_SB(1, 0), cB + kstep, voffB); PG8_STAGE(PG8_SA(1, 0), cA + kstep, voffA); PG8_STAGE(PG8_SB(1, 1), cB + hstepB + kstep, voffB);
        PG8_WAIT_V(6); PG8_BAR;
    }
    for (;;) {
        const bool has_next = S.next(ui + 1, nxt);
        const char* nA = has_next ? (const char*)g.A + (size_t)nxt.pm * tstep : cA; const char* nB = has_next ? (const char*)g.Bt + (size_t)nxt.pn * tstep : cB;
        for (int t = 0; t < nt; t += 2) {
            const bool last = (t == nt - 2);
            const char* a1 = cA + (size_t)(t + 1) * kstep;
            const char* a2 = last ? nA : cA + (size_t)(t + 2) * kstep; const char* b2 = last ? nB : cB + (size_t)(t + 2) * kstep;
            const char* a3 = a2 + kstep; const char* b3 = b2 + kstep;
            if (last && has_next) S.a_ready(nxt);
            if constexpr (SP2) {
            PG8_LDB(B0, 0, 0); PG8_LDB(B1, 0, 1); PG8_SCHED; PG8_LDA(At, 0, 0); PG8_STAGE(PG8_SA(1, 1), a1 + hstep, voffA);
            PG8_WAIT_V(8); PG8_WAIT_L(0); PG8_BAR; PG8_MMA(0, 0, At, B0); PG8_MMA(0, 1, At, B1); PG8_BAR; PG8_SCHED;
            PG8_LDA(At, 0, 1); PG8_STAGE(PG8_SB(0, 0), b2, voffB); PG8_STAGE(PG8_SB(0, 1), b2 + hstepB, voffB); PG8_STAGE(PG8_SA(0, 0), a2, voffA);
            PG8_WAIT_V(8); PG8_WAIT_L(0); PG8_BAR; PG8_MMA(1, 0, At, B0); PG8_MMA(1, 1, At, B1); PG8_BAR; PG8_SCHED;
            PG8_LDB(B0, 1, 0); PG8_LDB(B1, 1, 1); PG8_SCHED; PG8_LDA(At, 1, 0); PG8_STAGE(PG8_SA(0, 1), a2 + hstep, voffA);
            PG8_WAIT_V(8); PG8_WAIT_L(0); PG8_BAR; PG8_MMA(0, 0, At, B0); PG8_MMA(0, 1, At, B1); PG8_BAR; PG8_SCHED;
            PG8_LDA(At, 1, 1); PG8_STAGE(PG8_SB(1, 0), b3, voffB); PG8_STAGE(PG8_SB(1, 1), b3 + hstepB, voffB); PG8_STAGE(PG8_SA(1, 0), a3, voffA);
            PG8_WAIT_V(8); PG8_WAIT_L(0); PG8_BAR; PG8_MMA(1, 0, At, B0); PG8_MMA(1, 1, At, B1); PG8_BAR; PG8_SCHED;
            } else {
            PG8_LDB(B0, 0, 0); PG8_SCHED; PG8_LDA(At, 0, 0); PG8_STAGE(PG8_SA(1, 1), a1 + hstep, voffA);
            PG8_WAIT_L(8); PG8_BAR; PG8_WAIT_L(0); PG8_MMA(0, 0, At, B0); PG8_BAR; PG8_SCHED;
            PG8_LDB(B1, 0, 1); PG8_STAGE(PG8_SB(0, 0), b2, voffB);
            PG8_BAR; PG8_WAIT_L(0); PG8_MMA(0, 1, At, B1); PG8_BAR;
            PG8_LDA(At, 0, 1); PG8_STAGE(PG8_SA(0, 0), a2, voffA);
            PG8_BAR; PG8_WAIT_L(0); PG8_MMA(1, 0, At, B0); PG8_BAR; PG8_SCHED;
            PG8_STAGE(PG8_SB(0, 1), b2 + hstepB, voffB);
            PG8_WAIT_V(6); PG8_BAR; PG8_MMA(1, 1, At, B1); PG8_BAR;
            PG8_LDB(B0, 1, 0); PG8_SCHED; PG8_LDA(At, 1, 0); PG8_STAGE(PG8_SA(0, 1), a2 + hstep, voffA);
            PG8_WAIT_L(8); PG8_BAR; PG8_WAIT_L(0); PG8_MMA(0, 0, At, B0); PG8_BAR; PG8_SCHED;
            PG8_LDB(B1, 1, 1); PG8_STAGE(PG8_SB(1, 0), b3, voffB);
            PG8_BAR; PG8_WAIT_L(0); PG8_MMA(0, 1, At, B1); PG8_BAR;
            PG8_LDA(At, 1, 1); PG8_STAGE(PG8_SA(1, 0), a3, voffA);
            PG8_BAR; PG8_WAIT_L(0); PG8_MMA(1, 0, At, B0); PG8_BAR; PG8_SCHED;
            PG8_STAGE(PG8_SB(1, 1), b3 + hstepB, voffB);
            PG8_WAIT_V(6); PG8_BAR; PG8_MMA(1, 1, At, B1); PG8_BAR;
            }
        }
        if constexpr (ALIGN_EPI) { if (wr == 0) PG8_BAR; }
        if constexpr (!Epi::AFTER_DRAIN) { E(acc, cur, wr, wc, fr, fq); S.done(cur); }
        if (!has_next) break;
#pragma unroll
        for (int a = 0; a < 2; ++a)
#pragma unroll
            for (int b = 0; b < 2; ++b)
#pragma unroll
                for (int m = 0; m < 4; ++m)
#pragma unroll
                    for (int n = 0; n < 2; ++n) acc[a][b][m][n] = (f32x4){0.f, 0.f, 0.f, 0.f};
        cur = nxt; cA = nA; cB = nB; ++ui;
        if constexpr (ALIGN_EPI) { if (wr == 1) PG8_BAR; }
    }
    PG8_WAIT_V(0);
    if constexpr (!ALIGN_EPI) { if (wr == 0) PG8_BAR; }
    PG8_BAR;
    if constexpr (Epi::AFTER_DRAIN) { E.fused(acc, cur, wr, wc, fr, fq, lds, wid, lane); S.done(cur); }
#undef PG8_SA
#undef PG8_SB
#undef PG8_STAGE
#undef PG8_LDA
#undef PG8_LDB
#undef PG8_MMA
#undef PG8_WAIT_V
#undef PG8_WAIT_L
#undef PG8_BAR
#undef PG8_SCHED
}
}
#define XB_TMO      128
#define XB_XCNT(j)  (256  + 64 * (j))
#define XB_XSUB(j)  (1280 + 64 * (j))
#define XB_XGEN(j)  (2304 + 64 * (j))
#define XB_TOP      3328
#define XB_TOPGEN   3392
#define XCD_BAR_WORDS 3456
#define XB_SPIN_CAP (1u << 18)

__device__ __forceinline__ unsigned xb_ld(unsigned* p)              { return __hip_atomic_load(p, __ATOMIC_RELAXED, __HIP_MEMORY_SCOPE_AGENT); }
__device__ __forceinline__ unsigned xb_add(unsigned* p, unsigned v) { return __hip_atomic_fetch_add(p, v, __ATOMIC_RELAXED, __HIP_MEMORY_SCOPE_AGENT); }
__device__ __forceinline__ unsigned xb_xcc_id() { return (unsigned)__builtin_amdgcn_s_getreg((3 << 11) | 20) & 0xFu; }
#define XB_SPIN(cond, bar) do { unsigned _sp = 0; while (cond) { __builtin_amdgcn_s_sleep(1); \
    if ((++_sp & 255u) == 0u) { if (xb_ld(&(bar)[XB_TMO])) break; if (_sp > XB_SPIN_CAP) { atomicAdd(&(bar)[XB_TMO], 1u); break; } } } } while (0)

struct XcdBarrier {
    unsigned* bar; unsigned x;
    volatile LAS unsigned* st;
};

__device__ __forceinline__ XcdBarrier xcd_barrier_post(unsigned* bar, volatile LAS unsigned* st) {
    XcdBarrier b; b.bar = bar; b.x = xb_xcc_id(); b.st = st;
    if (threadIdx.x == 0) st[2] = xb_add(&bar[XB_XCNT(b.x)], 1u);
    return b;
}
__device__ __forceinline__ void xcd_barrier_complete(unsigned* bar, unsigned x, unsigned& nloc, unsigned& nx) {
    const unsigned G = gridDim.x * gridDim.y * gridDim.z;
    unsigned sum, cnt, mine, sp = 0u;
    for (;;) {
        sum = 0u; cnt = 0u; mine = 0u;
#pragma unroll
        for (unsigned j = 0; j < 16; ++j) { const unsigned c = xb_ld(&bar[XB_XCNT(j)]); sum += c; cnt += (c > 0u) ? 1u : 0u; mine = (j == x) ? c : mine; }
        if (sum == G) break;
        __builtin_amdgcn_s_sleep(1);
        if ((++sp & 255u) == 0u) { if (xb_ld(&bar[XB_TMO])) break; if (sp > XB_SPIN_CAP) { atomicAdd(&bar[XB_TMO], 1u); break; } }
    }
    nloc = mine > 0u ? mine : 1u; nx = cnt > 0u ? cnt : 1u;
}

__device__ __forceinline__ void xcd_barrier(const XcdBarrier& b) {
    asm volatile("s_waitcnt vmcnt(0)" ::: "memory");
    __syncthreads();
    if (threadIdx.x == 0) {
        unsigned* bar = b.bar;
        __builtin_amdgcn_s_waitcnt(0);
        unsigned nloc = b.st[0], nx = b.st[1];
        if (nloc == 0u) { xcd_barrier_complete(bar, b.x, nloc, nx); b.st[0] = nloc; b.st[1] = nx; }
        const unsigned old = xb_add(&bar[XB_XSUB(b.x)], 1u);
        const unsigned gen = old / nloc;
        if (old + 1u == (gen + 1u) * nloc) {
            __builtin_amdgcn_fence(__ATOMIC_RELEASE, "agent");
            asm volatile("s_waitcnt vmcnt(0)" ::: "memory");
            const unsigned og = xb_add(&bar[XB_TOP], 1u);
            const unsigned tg = og / nx;
            if (og + 1u == (tg + 1u) * nx) xb_add(&bar[XB_TOPGEN], 1u);
            else XB_SPIN(xb_ld(&bar[XB_TOPGEN]) == tg, bar);
            __builtin_amdgcn_fence(__ATOMIC_ACQUIRE, "agent");
            xb_add(&bar[XB_XGEN(b.x)], 1u);
            asm volatile("s_waitcnt vmcnt(0)" ::: "memory");
        } else {
            XB_SPIN(xb_ld(&bar[XB_XGEN(b.x)]) == gen, bar);
            __builtin_amdgcn_fence(__ATOMIC_ACQUIRE, "agent");
            asm volatile("s_waitcnt vmcnt(0)" ::: "memory");
        }
    }
    __syncthreads();
}

template <int CTRL> __device__ __forceinline__ float dppmov(float v) { return __builtin_bit_cast(float, __builtin_amdgcn_mov_dpp(__builtin_bit_cast(int, v), CTRL, 0xf, 0xf, true)); }
__device__ __forceinline__ void swap32(float& a, float& b) { auto r = __builtin_amdgcn_permlane32_swap(__builtin_bit_cast(unsigned, a), __builtin_bit_cast(unsigned, b), false, false); unsigned r0 = r[0], r1 = r[1]; asm volatile("" : "+v"(r0), "+v"(r1)); a = __builtin_bit_cast(float, r0); b = __builtin_bit_cast(float, r1); }
__device__ __forceinline__ void swap16(float& a, float& b) { auto r = __builtin_amdgcn_permlane16_swap(__builtin_bit_cast(unsigned, a), __builtin_bit_cast(unsigned, b), false, false); unsigned r0 = r[0], r1 = r[1]; asm volatile("" : "+v"(r0), "+v"(r1)); a = __builtin_bit_cast(float, r0); b = __builtin_bit_cast(float, r1); }
__device__ __forceinline__ float wave_sum_fast(float s) {
    s += dppmov<0xB1>(s); s += dppmov<0x4E>(s); s += dppmov<0x141>(s); s += dppmov<0x140>(s);
    { float a = s, b = s; swap16(a, b); s = a + b; }
    { float a = s, b = s; swap32(a, b); s = a + b; }
    return s;
}
template <bool FP8> __device__ __forceinline__ void rmsnorm_rows(const float* X, const float* g, h16* O, unsigned char* O8) {
    const int lane = otid() & 63; const int gw = (blockIdx.x * blockDim.x + otid()) >> 6, nw = (gridDim.x * blockDim.x) >> 6;
    float4 gg[4];
#pragma unroll
    for (int j = 0; j < 4; ++j) gg[j] = *(const float4*)(g + (lane + 64 * j) * 4);
    for (int t0 = gw; t0 < T; t0 += 2 * nw) {
        float4 v[2][4];
#pragma unroll
        for (int u = 0; u < 2; ++u) { const int t = t0 + u * nw; if (t < T) {
#pragma unroll
            for (int j = 0; j < 4; ++j) v[u][j] = ((const float4*)(X + (size_t)t * D))[lane + 64 * j]; } }
#pragma unroll
        for (int u = 0; u < 2; ++u) { const int t = t0 + u * nw; if (t < T) {
            float s = 0.f;
#pragma unroll
            for (int j = 0; j < 4; ++j) s += v[u][j].x * v[u][j].x + v[u][j].y * v[u][j].y + v[u][j].z * v[u][j].z + v[u][j].w * v[u][j].w;
            const float r = rsqrtf(wave_sum_fast(s) * (1.f / D) + EPS);
#pragma unroll
            for (int j = 0; j < 4; ++j) { const int cc = (lane + 64 * j) * 4;
                const float a0 = v[u][j].x * r * gg[j].x, a1 = v[u][j].y * r * gg[j].y, a2 = v[u][j].z * r * gg[j].z, a3 = v[u][j].w * r * gg[j].w;
                uint2 w; w.x = pkh(a0, a1); w.y = pkh(a2, a3);
                *(uint2*)(O + (size_t)t * D + cc) = w;
                if (FP8) *(unsigned*)(O8 + (size_t)t * D + cc) = q8(a0 * 16.f) | (q8(a1 * 16.f) << 8) | (q8(a2 * 16.f) << 16) | (q8(a3 * 16.f) << 24); } } }
    }
}

__device__ __forceinline__ void prep_w2(const P& p) {
    h16* W2T = (h16*)(p.ws + WS_WQ);
    const int lane = otid() & 63, r32 = lane & 31, hi = lane >> 5; const int gw = (blockIdx.x * blockDim.x + otid()) >> 6, nw = (gridDim.x * blockDim.x) >> 6;
    for (int tile = gw; tile < 16 * 4 * 32; tile += nw) {
        const int hc = tile >> 7, nt = (tile >> 5) & 3, kt = tile & 31;
        const float* ap = p.subk + ((size_t)hc * 128 + 32 * nt + r32) * 128 + hi * 8;
        const float* bp = p.wq + (size_t)(32 * kt + r32) * QW + hc * 128 + hi * 8;
        f32x16 acc;
#pragma unroll
        for (int r = 0; r < 16; ++r) acc[r] = 0.f;
#pragma unroll
        for (int ks = 0; ks < 8; ++ks) {
            const float4 a0 = *(const float4*)(ap + ks * 16), a1 = *(const float4*)(ap + ks * 16 + 4), b0 = *(const float4*)(bp + ks * 16), b1 = *(const float4*)(bp + ks * 16 + 4);
            const h16x8 af = {(h16)a0.x, (h16)a0.y, (h16)a0.z, (h16)a0.w, (h16)a1.x, (h16)a1.y, (h16)a1.z, (h16)a1.w};
            const h16x8 bf = {(h16)b0.x, (h16)b0.y, (h16)b0.z, (h16)b0.w, (h16)b1.x, (h16)b1.y, (h16)b1.z, (h16)b1.w};
            acc = __builtin_amdgcn_mfma_f32_32x32x16_f16(af, bf, acc, 0, 0, 0); }
        h16* op = W2T + ((size_t)hc * 128 + 32 * nt) * D + 32 * kt + r32;
#pragma unroll
        for (int r = 0; r < 16; ++r) op[(size_t)((r & 3) + 8 * (r >> 2) + 4 * hi) * D] = (h16)acc[r];
    }
}

__device__ __forceinline__ void transpose_item(const float* W, int N, h16* WT, float* scr, int item, int lane) {
    const int nblk = N / 32, kb = item / nblk, nb = item % nblk, k0 = 64 * kb, n0 = 32 * nb;
#pragma unroll 8
    for (int i = 0; i < 32; ++i) { const int kk = 2 * i + (lane >> 5); scr[kk * 33 + (lane & 31)] = W[(size_t)(k0 + kk) * N + n0 + (lane & 31)]; }
    const int cch = lane & 7;
#pragma unroll
    for (int j = 0; j < 4; ++j) { const int n = (lane >> 3) + 8 * j; const float* s = scr + (8 * cch) * 33 + n;
        uint4 o; o.x = pkh(s[0 * 33], s[1 * 33]); o.y = pkh(s[2 * 33], s[3 * 33]); o.z = pkh(s[4 * 33], s[5 * 33]); o.w = pkh(s[6 * 33], s[7 * 33]);
        *(uint4*)(WT + (size_t)(n0 + n) * D + k0 + 8 * cch) = o; }
}
__device__ __forceinline__ void table_item(const P& p, size_t i) {
    uint4 wu, wv; unsigned* pu = (unsigned*)&wu; unsigned* pv = (unsigned*)&wv;
#pragma unroll
    for (int j = 0; j < 4; ++j) { const float4 a = ((const float4*)p.u)[i * 4 + j], b = ((const float4*)p.v)[i * 4 + j];
        pu[j] = q8(a.x * 512.f) | (q8(a.y * 512.f) << 8) | (q8(a.z * 512.f) << 16) | (q8(a.w * 512.f) << 24);
        pv[j] = q8(b.x * 128.f) | (q8(b.y * 128.f) << 8) | (q8(b.z * 128.f) << 16) | (q8(b.w * 128.f) << 24); }
    const size_t e_ = i >> 6, ch = i & 63, so = (ch >> 3) * ((size_t)16384 * 128) + e_ * 128 + (ch & 7) * 16;
    *(uint4*)(p.ws + WS_U + so) = wu; *(uint4*)(p.ws + WS_V + so) = wv;
}
__device__ __forceinline__ void ph_prep(const P& p, unsigned char* lds) {
    h16* WinT = (h16*)(p.ws + WS_WIN); h16* WoutT = (h16*)(p.ws + WS_WOUT); float* LB = (float*)(p.ws + WS_LB);
    const size_t gid = (size_t)blockIdx.x * blockDim.x + otid(), gs = (size_t)gridDim.x * blockDim.x;
    for (size_t i = gid; i < (size_t)NB_ * 8 * 512; i += gs) ((float*)(p.ws + WS_KM))[i] = 0.f;
    for (size_t i = gid; i < (size_t)T; i += gs) ((float*)(p.ws + WS_SS))[i] = 0.f;
    for (size_t i = gid; i < 512; i += gs) { const float a = p.lb_logits[i], b = p.lb_logits[512 + i]; const float m = fmaxf(a, b); const float ea = __expf(a - m), eb = __expf(b - m); LB[i] = ea / (ea + eb); }
    { float* scr = (float*)(lds + (otid() >> 6) * 16384); const int lane_ = otid() & 63; const int gw_ = (blockIdx.x * blockDim.x + otid()) >> 6, nw_ = (gridDim.x * blockDim.x) >> 6;
      constexpr int I_IN = (D / 64) * (INC / 32), I_OUT = (D / 64) * (D / 32);
      for (int it = gw_; it < I_IN + I_OUT; it += nw_) { if (it < I_IN) transpose_item(p.w_in, INC, WinT, scr, it, lane_); else transpose_item(p.w_out, D, WoutT, scr, it - I_IN, lane_); } }
    prep_w2(p);
    rmsnorm_rows<false>(p.x, p.g1, (h16*)(p.ws + WS_XN), nullptr);
}

typedef short v4i16_t __attribute__((ext_vector_type(4)));
typedef _Float16 h16x4 __attribute__((ext_vector_type(4)));
#define LAS3 __attribute__((address_space(3)))
__device__ __forceinline__ h16x4 tr16(const LAS3 unsigned char* p) { return __builtin_bit_cast(h16x4, __builtin_amdgcn_ds_read_tr16_b64_v4i16((LAS3 v4i16_t*)p)); }
__device__ __forceinline__ h16x8 pk8(const f32x16& v, int b) {
    typedef unsigned u32x4_t __attribute__((ext_vector_type(4)));
    u32x4_t w; w.x = pkh(v[b], v[b + 1]); w.y = pkh(v[b + 2], v[b + 3]); w.z = pkh(v[b + 4], v[b + 5]); w.w = pkh(v[b + 6], v[b + 7]);
    return __builtin_bit_cast(h16x8, w);
}
__device__ __forceinline__ void glds16(const void* g, unsigned ldsoff) {
    unsigned keep;
    asm volatile("s_mov_b32 %0, m0\n\ts_mov_b32 m0, %2\n\ts_nop 0\n\tglobal_load_lds_dwordx4 %1, off\n\ts_mov_b32 m0, %0" : "=&s"(keep) : "v"(g), "s"(ldsoff) : "memory");
}
__device__ __forceinline__ void ph_attn(const P& p, unsigned char* lds) {
    const h16* PROJ = (const h16*)(p.ws + WS_PROJ); const float* KM = (const float*)(p.ws + WS_KM); h16* MIX = (h16*)(p.ws + WS_XN);
    const int tid = otid(), lane = tid & 63, wid = __builtin_amdgcn_readfirstlane(tid >> 6), r32 = lane & 31, hi = lane >> 5;
    const LAS3 unsigned char* lds3 = (const LAS3 unsigned char*)lds; const unsigned ldsb = (unsigned)(__SIZE_TYPE__)(LAS3 unsigned char*)lds;
    float* wsf = (float*)(lds + 98304) + wid * 64;
    constexpr float C2 = 0.125f * 1.4426950408889634f;
    const int k_key = wid * 8 + (lane >> 3), k_c = (lane & 7) ^ (lane >> 3);
    const int v_key = (wid & 3) * 16 + (lane >> 2), v_col = (wid >> 2) * 32 + (lane & 3) * 8;
    const int vaddr = 16384 + ((lane >> 4) & 1) * 32 + (lane & 3) * 8 + (4 * hi + ((lane & 15) >> 2)) * 64;
    const int kaddr = r32 * 128;
    unsigned* qctr = (unsigned*)p.ws + 4000;
    volatile unsigned* qsl = (volatile unsigned*)(lds + 140032);
    if (wid >= 4) __builtin_amdgcn_s_setprio(1);
    for (;;) {
        asm volatile("s_waitcnt lgkmcnt(0)" ::: "memory"); __builtin_amdgcn_s_barrier(); asm volatile("" ::: "memory");
        if (tid == 0) qsl[0] = atomicAdd(qctr, 1u);
        asm volatile("s_waitcnt lgkmcnt(0)" ::: "memory"); __builtin_amdgcn_s_barrier(); asm volatile("" ::: "memory");
        const unsigned qi = __builtin_amdgcn_readfirstlane(qsl[0]);
        if (qi >= (unsigned)(NB_ * AH * 8 + 256)) break;
        if (qi % 9u == 8u) {
            const size_t ib = (size_t)(qi / 9u) * 4096 + tid;
#pragma unroll 2
            for (int it = 0; it < 8; ++it) table_item(p, ib + (size_t)it * 512);
            continue; }
        const unsigned unit = qi - qi / 9u;
        const int own = 7 - (int)(unit >> 8), bh = (int)(unit & 255u);
        {
        const int b = bh >> 3, h = bh & 7; const float sl2 = exp2f(-(float)(h + 1)) * 1.4426950408889634f;
        const h16* Kg = PROJ + (size_t)b * S * INC + C_KA + h * 64 + (size_t)k_key * INC + k_c * 8;
        const h16* Vg = PROJ + (size_t)b * S * INC + C_VA + h * 64 + (size_t)v_key * INC + v_col;
#define ATT_KB(t_) (((t_) < 4) ? own * 256 + (t_) * 64 : ((t_) - 4) * 64)
#define ATT_GLDS(pair_, st_) do { _Pragma("unroll") for (int s_ = 0; s_ < 2; ++s_) { const int kb_ = ATT_KB(2 * (pair_) + s_); \
            glds16(Kg + (size_t)kb_ * INC, ldsb + (st_) * 32768 + s_ * 8192 + wid * 1024); \
            glds16(Vg + (size_t)kb_ * INC, ldsb + (st_) * 32768 + 16384 + s_ * 8192 + wid * 1024); } } while (0)
        ATT_GLDS(0, 0); ATT_GLDS(1, 1);
            const int qrel = wid * 32 + r32, qpos = own * 256 + qrel;
            h16x8 qf[4];
            { const h16* qp = PROJ + (size_t)(b * S + qpos) * INC + C_QA + h * 64 + hi * 8;
#pragma unroll
              for (int ks = 0; ks < 4; ++ks) { const h16x8 raw = *(const h16x8*)(qp + ks * 16);
#pragma unroll
                  for (int e = 0; e < 8; ++e) qf[ks][e] = (h16)((float)raw[e] * C2); } }
            unsigned selbits = 0;
            { float* gsc = (float*)(lds + 100352) + wid * 512 + lane;
#pragma unroll 1
              for (int j = 0; j < own; ++j) { float a = 0.f; const float* km = KM + (size_t)(b * 8 + j) * 512 + h * 64 + hi * 8;
#pragma unroll
                  for (int ks = 0; ks < 4; ++ks) { const float4 k0 = *(const float4*)(km + ks * 16), k1 = *(const float4*)(km + ks * 16 + 4);
                      a += (float)qf[ks][0] * k0.x + (float)qf[ks][1] * k0.y + (float)qf[ks][2] * k0.z + (float)qf[ks][3] * k0.w
                         + (float)qf[ks][4] * k1.x + (float)qf[ks][5] * k1.y + (float)qf[ks][6] * k1.z + (float)qf[ks][7] * k1.w; }
                  a += __shfl_xor(a, 32); gsc[j * 64] = a; }
              float g[8];
#pragma unroll
              for (int j = 0; j < 8; ++j) { const float a = gsc[j * 64]; g[j] = (j < own) ? a : -INFINITY; }
#pragma unroll
              for (int rnd = 0; rnd < 3; ++rnd) { float best = -INFINITY; int bi = -1;
#pragma unroll
                  for (int j = 0; j < 8; ++j) { const bool t_ = !((selbits >> j) & 1) && g[j] > best; best = t_ ? g[j] : best; bi = t_ ? j : bi; }
                  if (bi >= 0) selbits |= 1u << bi; } }
            float m_run = 0.f, l_run = 0.f; f32x16 o0, o1;
#pragma unroll
            for (int r = 0; r < 16; ++r) { o0[r] = 0.f; o1[r] = 0.f; }
            const int NP = 2 + 2 * own;
            int st = 0;
            for (int tp = 0; tp < NP; ++tp) {
                if (tp + 1 < NP) asm volatile("s_waitcnt vmcnt(4)" ::: "memory"); else asm volatile("s_waitcnt vmcnt(0)" ::: "memory");
                asm volatile("s_waitcnt lgkmcnt(0)" ::: "memory"); __builtin_amdgcn_s_barrier();
                if (tp + 2 < NP) { const int st2 = (st == 0) ? 2 : st - 1; ATT_GLDS(tp + 2, st2); }
                {
                const int t0 = 2 * tp; const int kb0 = ATT_KB(t0);
                bool need0, need1; float maskadd = 0.f;
                if (t0 < 4) { need0 = (t0 <= (wid >> 1)); need1 = (t0 + 1 <= (wid >> 1)); }
                else { const bool sel = (selbits >> ((t0 - 4) >> 2)) & 1; need0 = need1 = (__any(sel) != 0); maskadd = sel ? 0.f : -INFINITY; }
                if (need0) {
                    const int bo = st * 32768;
                    float sl2v = sl2; asm volatile("" : "+v"(sl2v));
                    const float base2 = -sl2v * (float)(qpos - kb0) + maskadd - m_run + sl2v * (float)(4 * hi);
                    const float base3 = need1 ? base2 + sl2v * 64.f : -INFINITY;
                    f32x16 p0, p1, p2, p3;
#pragma unroll
                    for (int r = 0; r < 16; ++r) { const float c_ = sl2v * (float)((r & 3) + 8 * (r >> 2)), d_ = sl2v * (float)(32 + (r & 3) + 8 * (r >> 2));
                        p0[r] = base2 + c_; p1[r] = base2 + d_; p2[r] = base3 + c_; p3[r] = base3 + d_; }
#pragma unroll
                    for (int ks = 0; ks < 4; ++ks) { const int c = 2 * ks + hi; const LAS3 unsigned char* kp = lds3 + bo + kaddr + ((c ^ (r32 & 7)) * 16);
                        const h16x8 a0 = *(const LAS3 h16x8*)(kp), a1 = *(const LAS3 h16x8*)(kp + 4096), a2 = *(const LAS3 h16x8*)(kp + 8192), a3 = *(const LAS3 h16x8*)(kp + 8192 + 4096);
                        p0 = __builtin_amdgcn_mfma_f32_32x32x16_f16(a0, qf[ks], p0, 0, 0, 0); p1 = __builtin_amdgcn_mfma_f32_32x32x16_f16(a1, qf[ks], p1, 0, 0, 0);
                        p2 = __builtin_amdgcn_mfma_f32_32x32x16_f16(a2, qf[ks], p2, 0, 0, 0); p3 = __builtin_amdgcn_mfma_f32_32x32x16_f16(a3, qf[ks], p3, 0, 0, 0); }
                    if (t0 < 4) {
                        const float limf = (float)(qrel - t0 * 64 - 4 * hi);
#pragma unroll
                        for (int r = 0; r < 16; ++r) { const float k_ = (float)((r & 3) + 8 * (r >> 2));
                            p0[r] = __builtin_fmaf(__builtin_fminf(limf - k_, 0.f), 1e30f, p0[r]); p1[r] = __builtin_fmaf(__builtin_fminf(limf - (k_ + 32.f), 0.f), 1e30f, p1[r]);
                            p2[r] = __builtin_fmaf(__builtin_fminf(limf - (k_ + 64.f), 0.f), 1e30f, p2[r]); p3[r] = __builtin_fmaf(__builtin_fminf(limf - (k_ + 96.f), 0.f), 1e30f, p3[r]); } }
                    float rm, rm2;
                    { rm = __builtin_fmaxf(__builtin_fmaxf(p0[0], p0[1]), p1[0]); rm2 = __builtin_fmaxf(__builtin_fmaxf(p2[0], p2[1]), p3[0]);
                      rm = __builtin_fmaxf(__builtin_fmaxf(rm, p1[1]), p0[2]); rm2 = __builtin_fmaxf(__builtin_fmaxf(rm2, p3[1]), p2[2]);
                      rm = __builtin_fmaxf(__builtin_fmaxf(rm, p0[3]), p1[2]); rm2 = __builtin_fmaxf(__builtin_fmaxf(rm2, p2[3]), p3[2]);
                      rm = __builtin_fmaxf(rm, p1[3]); rm2 = __builtin_fmaxf(rm2, p3[3]);
#pragma unroll
                      for (int r = 4; r < 16; r += 2) { rm = __builtin_fmaxf(__builtin_fmaxf(rm, p0[r]), p0[r + 1]); rm2 = __builtin_fmaxf(__builtin_fmaxf(rm2, p2[r]), p2[r + 1]);
                          rm = __builtin_fmaxf(__builtin_fmaxf(rm, p1[r]), p1[r + 1]); rm2 = __builtin_fmaxf(__builtin_fmaxf(rm2, p3[r]), p3[r + 1]); }
                      rm = __builtin_fmaxf(rm, rm2); }
                    rm = fmaxf(rm, __shfl_xor(rm, 32));
                    float dl = 0.f; bool resc = false;
                    if (tp == 0) { dl = rm; m_run = rm; }
                    else if (__any(rm > 8.f)) { dl = fmaxf(rm, 0.f); m_run += dl; resc = true; }
                    { typedef float f32x2p __attribute__((ext_vector_type(2))); const f32x2p dl2 = {dl, dl};
#define ATT_PKSUB(P) _Pragma("unroll") for (int r = 0; r < 16; r += 2) { f32x2p t_ = {P[r], P[r + 1]}; asm("v_pk_add_f32 %0, %0, %1 neg_lo:[0,1] neg_hi:[0,1]" : "+v"(t_) : "v"(dl2)); P[r] = t_[0]; P[r + 1] = t_[1]; }
                      ATT_PKSUB(p0) ATT_PKSUB(p1) ATT_PKSUB(p2) ATT_PKSUB(p3)
#undef ATT_PKSUB
                    }
                    if (resc) { const float f = __builtin_amdgcn_exp2f(-dl); l_run *= f; if (hi == 0) wsf[r32] = f;
#pragma unroll
                        for (int r = 0; r < 16; ++r) { const float fr_ = wsf[(r & 3) + 8 * (r >> 2) + 4 * hi]; o0[r] *= fr_; o1[r] *= fr_; } }
#pragma unroll
                    for (int r = 0; r < 16; ++r) { p0[r] = __builtin_amdgcn_exp2f(p0[r]); p1[r] = __builtin_amdgcn_exp2f(p1[r]); p2[r] = __builtin_amdgcn_exp2f(p2[r]); p3[r] = __builtin_amdgcn_exp2f(p3[r]); }
                    { const f32x16 t = (p0 + p1) + (p2 + p3);
                      typedef float f32x8s __attribute__((ext_vector_type(8))); typedef float f32x4s __attribute__((ext_vector_type(4))); typedef float f32x2s __attribute__((ext_vector_type(2)));
                      const f32x8s t8 = __builtin_shufflevector(t, t, 0, 1, 2, 3, 4, 5, 6, 7) + __builtin_shufflevector(t, t, 8, 9, 10, 11, 12, 13, 14, 15);
                      const f32x4s t4 = __builtin_shufflevector(t8, t8, 0, 1, 2, 3) + __builtin_shufflevector(t8, t8, 4, 5, 6, 7);
                      const f32x2s t2 = __builtin_shufflevector(t4, t4, 0, 1) + __builtin_shufflevector(t4, t4, 2, 3);
                      l_run += t2[0] + t2[1]; }
                    const h16x8 pa0 = pk8(p0, 0), pa1 = pk8(p0, 8), pa2 = pk8(p1, 0), pa3 = pk8(p1, 8), pa4 = pk8(p2, 0), pa5 = pk8(p2, 8), pa6 = pk8(p3, 0), pa7 = pk8(p3, 8);
                    const LAS3 unsigned char* vp = lds3 + bo + vaddr;
#define VFR_(off) ({ const h16x4 lo_ = tr16(vp + (off)), hh_ = tr16(vp + (off) + 512); (h16x8){lo_[0], lo_[1], lo_[2], lo_[3], hh_[0], hh_[1], hh_[2], hh_[3]}; })
                    o0 = __builtin_amdgcn_mfma_f32_32x32x16_f16(pa0, VFR_(0), o0, 0, 0, 0);           o1 = __builtin_amdgcn_mfma_f32_32x32x16_f16(pa0, VFR_(4096), o1, 0, 0, 0);
                    o0 = __builtin_amdgcn_mfma_f32_32x32x16_f16(pa1, VFR_(1024), o0, 0, 0, 0);        o1 = __builtin_amdgcn_mfma_f32_32x32x16_f16(pa1, VFR_(4096 + 1024), o1, 0, 0, 0);
                    o0 = __builtin_amdgcn_mfma_f32_32x32x16_f16(pa2, VFR_(2048), o0, 0, 0, 0);        o1 = __builtin_amdgcn_mfma_f32_32x32x16_f16(pa2, VFR_(4096 + 2048), o1, 0, 0, 0);
                    o0 = __builtin_amdgcn_mfma_f32_32x32x16_f16(pa3, VFR_(3072), o0, 0, 0, 0);        o1 = __builtin_amdgcn_mfma_f32_32x32x16_f16(pa3, VFR_(4096 + 3072), o1, 0, 0, 0);
                    o0 = __builtin_amdgcn_mfma_f32_32x32x16_f16(pa4, VFR_(8192), o0, 0, 0, 0);        o1 = __builtin_amdgcn_mfma_f32_32x32x16_f16(pa4, VFR_(8192 + 4096), o1, 0, 0, 0);
                    o0 = __builtin_amdgcn_mfma_f32_32x32x16_f16(pa5, VFR_(8192 + 1024), o0, 0, 0, 0); o1 = __builtin_amdgcn_mfma_f32_32x32x16_f16(pa5, VFR_(8192 + 4096 + 1024), o1, 0, 0, 0);
                    o0 = __builtin_amdgcn_mfma_f32_32x32x16_f16(pa6, VFR_(8192 + 2048), o0, 0, 0, 0); o1 = __builtin_amdgcn_mfma_f32_32x32x16_f16(pa6, VFR_(8192 + 4096 + 2048), o1, 0, 0, 0);
                    o0 = __builtin_amdgcn_mfma_f32_32x32x16_f16(pa7, VFR_(8192 + 3072), o0, 0, 0, 0); o1 = __builtin_amdgcn_mfma_f32_32x32x16_f16(pa7, VFR_(8192 + 4096 + 3072), o1, 0, 0, 0);
#undef VFR_
                }
                }
                st = (st == 2) ? 0 : st + 1;
            }
#undef ATT_KB
#undef ATT_GLDS
            { const float lt = l_run + __shfl_xor(l_run, 32); if (hi == 0) wsf[32 + r32] = lt;
              int hi_ = hi; asm volatile("" : "+v"(hi_));
              unsigned char* ot = lds + 100352 + wid * 4608;
#pragma unroll
              for (int r = 0; r < 16; ++r) { const int qr = (r & 3) + 8 * (r >> 2) + 4 * hi_; const float rl = __builtin_amdgcn_rcpf(wsf[32 + qr]);
                  *(h16*)(ot + qr * 144 + r32 * 2) = (h16)(o0[r] * rl); *(h16*)(ot + qr * 144 + 64 + r32 * 2) = (h16)(o1[r] * rl); }
              h16* Ow = MIX + (size_t)(b * S + own * 256 + wid * 32) * D + h * 64;
              typedef unsigned u32x4e __attribute__((ext_vector_type(4)));
#pragma unroll
              for (int i = 0; i < 4; ++i) { const int pc = lane + 64 * i, row = pc >> 3, q = pc & 7;
                  *(u32x4e*)(Ow + (size_t)row * D + q * 8) = *(const u32x4e*)(ot + row * 144 + q * 16); } }
        }
    }
    __builtin_amdgcn_s_setprio(0);
}
typedef __bf16 bf16x8 __attribute__((ext_vector_type(8)));
typedef __bf16 bf16x4 __attribute__((ext_vector_type(4)));
typedef float f32x4v __attribute__((ext_vector_type(4)));
__device__ __forceinline__ int offRM(int row, int col) { const int c = col >> 3; return c * 1024 + ((row ^ (c & 7)) << 4) + ((col & 7) << 1); }
__device__ __forceinline__ int offST(int v, int d) { const int c = d >> 3; return c * 2048 + ((v ^ (c & 7)) << 4) + ((d & 7) << 1); }
__device__ __forceinline__ int offSC(int t, int s) { const int c = s >> 3; return c * 1024 + ((t ^ c) << 4) + ((s & 7) << 1); }
__device__ __forceinline__ unsigned short bf16bits(float x) { const __bf16 h = (__bf16)x; return __builtin_bit_cast(unsigned short, h); }
__device__ __forceinline__ bf16x8 tr_frag(const LAS3 unsigned char* img, int k0, int n0, int lane) {
    const int li = lane & 15, q = li >> 2, pp = li & 3, ncol = n0 + 16 * ((lane >> 4) & 1) + 4 * pp, row = k0 + 8 * (lane >> 5) + q;
    const bf16x4 lo = __builtin_bit_cast(bf16x4, __builtin_amdgcn_ds_read_tr16_b64_v4i16((LAS3 v4i16_t*)(img + offRM(row, ncol))));
    const bf16x4 hh = __builtin_bit_cast(bf16x4, __builtin_amdgcn_ds_read_tr16_b64_v4i16((LAS3 v4i16_t*)(img + offRM(row + 4, ncol))));
    return (bf16x8){lo[0], lo[1], lo[2], lo[3], hh[0], hh[1], hh[2], hh[3]};
}
#define HG_BAR() do { asm volatile("s_waitcnt lgkmcnt(0)" ::: "memory"); __builtin_amdgcn_s_barrier(); asm volatile("" ::: "memory"); } while (0)
__device__ __forceinline__ void ph_hgrn(const P& p, unsigned char* lds) {
    const h16* PROJ = (const h16*)(p.ws + WS_PROJ); const float* LB = (const float*)(p.ws + WS_LB); h16* MIX = (h16*)(p.ws + WS_XN);
    constexpr int R0 = 0, QT = 32768, KT = 49152, QH = 65536, VV = 81920, SC = 98304, STo = 106496, TOT = 139264, EL = 141312, FD = 141824;
    const int tid0 = otid(), wid = __builtin_amdgcn_readfirstlane(tid0 >> 6);
    const LAS3 unsigned char* lds3 = (const LAS3 unsigned char*)lds;
    for (int item = blockIdx.x; item < NB_ * RH; item += gridDim.x) {
        const int tid = tid0;
        const int b = item / RH, hd = item % RH;
        f32x16 S0, S1;
#pragma unroll
        for (int r = 0; r < 16; ++r) { S0[r] = 0.f; S1[r] = 0.f; }
        __syncthreads();
        for (int i = tid; i < 2048; i += NTHR) *(uint4*)(lds + STo + i * 16) = make_uint4(0u, 0u, 0u, 0u);
        const float lbv = LB[hd * 128 + (tid & 127)];
        const float4 ngv = *(const float4*)(p.rec_g + hd * 128 + (tid & 31) * 4);
        typedef unsigned u32x4h __attribute__((ext_vector_type(4)));
        u32x4h pfF[2], pfQ[2]; h16x8 pfV[2];
#pragma unroll
        for (int j = 0; j < 2; ++j) { const int i = tid + NTHR * j, row = i >> 4, c16 = i & 15; const h16* src = PROJ + ((size_t)b * S + row) * INC + hd * 128 + c16 * 8;
            pfF[j] = *(const u32x4h*)(src + C_FR); pfQ[j] = *(const u32x4h*)(src + C_QR); pfV[j] = *(const h16x8*)(src + C_IR); }
#pragma unroll 1
        for (int ck = 0; ck < S / 64; ++ck) {
            int tid = tid0; asm volatile("" : "+v"(tid));
            const int lane = tid & 63, r32 = lane & 31, hi = lane >> 5;
            const size_t tok0 = (size_t)b * S + ck * 64;
#pragma unroll
            for (int j = 0; j < 2; ++j) { const int i = tid + NTHR * j, row = i >> 4, c16 = i & 15;
                *(u32x4h*)(lds + R0 + row * 256 + c16 * 16) = pfF[j]; *(u32x4h*)(lds + R0 + 16384 + row * 256 + c16 * 16) = pfQ[j];
                bf16x8 vb;
#pragma unroll
                for (int e = 0; e < 8; ++e) vb[e] = (__bf16)(float)pfV[j][e];
                *(bf16x8*)(lds + VV + offRM(row, c16 * 8)) = vb; }
            if (ck + 1 < S / 64) {
#pragma unroll
                for (int j = 0; j < 2; ++j) { const int i = tid + NTHR * j, row = i >> 4, c16 = i & 15; const h16* src = PROJ + (tok0 + 64 + row) * INC + hd * 128 + c16 * 8;
                    pfF[j] = *(const u32x4h*)(src + C_FR); pfQ[j] = *(const u32x4h*)(src + C_QR); pfV[j] = *(const h16x8*)(src + C_IR); } }
            HG_BAR();
            unsigned gq0[4], gq1[4];
#pragma unroll
            for (int it = 0; it < 4; ++it) { const uint2 t_ = *(const uint2*)(PROJ + (tok0 + it * 16 + wid * 2 + hi) * INC + C_GR + hd * 128 + r32 * 4); gq0[it] = t_.x; gq1[it] = t_.y; }
            const int d = tid & 127, tq = tid >> 7;
            float cumv[16], kkv[16], qfv[16];
            { float run = 0.f;
#pragma unroll
              for (int j = 0; j < 16; ++j) { const int t = tq * 16 + j;
                  const float fp = (float)*(const h16*)(lds + R0 + t * 256 + d * 2), qv = (float)*(const h16*)(lds + R0 + 16384 + t * 256 + d * 2);
                  const float f = lbv + (1.f - lbv) * sigmoidf_(fp); run += __builtin_amdgcn_logf(f);        cumv[j] = run; kkv[j] = 1.f - f; qfv[j] = qv * sigmoidf_(qv); }
              ((float*)(lds + TOT))[tq * 128 + d] = run; }
            HG_BAR();
            { const float* tot = (const float*)(lds + TOT); const float t0 = tot[d], t1 = tot[128 + d], t2 = tot[256 + d], t3 = tot[384 + d];
              const float cmid = t0 + t1, last = cmid + t2 + t3; const float off = (tq == 0) ? 0.f : (tq == 1) ? t0 : (tq == 2) ? cmid : cmid + t2;
              const float emid = __builtin_amdgcn_exp2f(cmid);
              if (tq == 0) { ((float*)(lds + EL))[d] = __builtin_amdgcn_exp2f(last); ((float*)(lds + FD))[d] = __builtin_amdgcn_exp2f(last - cmid); }
#pragma unroll
              for (int j = 0; j < 16; ++j) { const int t = tq * 16 + j; const float cm = off + cumv[j] - cmid; const float eq = __builtin_amdgcn_exp2f(cm); const float qt = qfv[j] * eq;
                  const int o = offRM(t, d);
                  *(unsigned short*)(lds + QT + o) = bf16bits(qt); *(unsigned short*)(lds + QH + o) = bf16bits(qt * emid); *(unsigned short*)(lds + KT + o) = bf16bits(kkv[j] * __builtin_amdgcn_rcpf(eq)); } }
            HG_BAR();
            if (wid < 3) {
                const int tt = (wid >= 1), st = (wid == 2);
                f32x16 acc;
#pragma unroll
                for (int r = 0; r < 16; ++r) acc[r] = 0.f;
#pragma unroll
                for (int kd = 0; kd < 8; ++kd) { const int cc = 2 * kd + hi;
                    const bf16x8 a = *(const LAS3 bf16x8*)(lds3 + QT + cc * 1024 + (((32 * tt + r32) ^ (cc & 7)) << 4));
                    const bf16x8 bb = *(const LAS3 bf16x8*)(lds3 + KT + cc * 1024 + (((32 * st + r32) ^ (cc & 7)) << 4));
                    acc = __builtin_amdgcn_mfma_f32_32x32x16_bf16(a, bb, acc, 0, 0, 0); }
#pragma unroll
                for (int r = 0; r < 16; ++r) { const int tr_ = (r & 3) + 8 * (r >> 2) + 4 * hi; float x = acc[r]; if (tt == st && r32 > tr_) x = 0.f;
                    *(unsigned short*)(lds + SC + offSC(32 * tt + tr_, 32 * st + r32)) = bf16bits(x); }
            }
            HG_BAR();
            { const int th = wid >> 2, vt = wid & 3;
              f32x16 acc;
#pragma unroll
              for (int r = 0; r < 16; ++r) acc[r] = 0.f;
#pragma unroll
              for (int ks = 0; ks < 4; ++ks) { if (ks < 2 || th == 1) { const int cs = 2 * ks + hi;
                  const bf16x8 a = *(const LAS3 bf16x8*)(lds3 + SC + cs * 1024 + (((32 * th + r32) ^ cs) << 4));
                  const bf16x8 bb = tr_frag(lds3 + VV, 16 * ks, 32 * vt, lane);
                  acc = __builtin_amdgcn_mfma_f32_32x32x16_bf16(a, bb, acc, 0, 0, 0); } }
#pragma unroll
              for (int kd = 0; kd < 8; ++kd) { const int cc = 2 * kd + hi;
                  const bf16x8 a = *(const LAS3 bf16x8*)(lds3 + QH + cc * 1024 + (((32 * th + r32) ^ (cc & 7)) << 4));
                  const bf16x8 bb = *(const LAS3 bf16x8*)(lds3 + STo + cc * 2048 + (((32 * vt + r32) ^ (cc & 7)) << 4));
                  acc = __builtin_amdgcn_mfma_f32_32x32x16_bf16(a, bb, acc, 0, 0, 0); }
#pragma unroll
              for (int r = 0; r < 16; ++r) ((float*)(lds + R0))[(32 * th + (r & 3) + 8 * (r >> 2) + 4 * hi) * 128 + 32 * vt + r32] = acc[r]; }
            HG_BAR();
            { const int dt = wid >> 1;
#pragma unroll
              for (int vi = 0; vi < 2; ++vi) { const int vt = 2 * (wid & 1) + vi;
                  f32x16 acc;
#pragma unroll
                  for (int r = 0; r < 16; ++r) acc[r] = 0.f;
#pragma unroll
                  for (int ks = 0; ks < 4; ++ks) { const bf16x8 a = tr_frag(lds3 + KT, 16 * ks, 32 * dt, lane); const bf16x8 bb = tr_frag(lds3 + VV, 16 * ks, 32 * vt, lane);
                      acc = __builtin_amdgcn_mfma_f32_32x32x16_bf16(a, bb, acc, 0, 0, 0); }
#pragma unroll
                  for (int g = 0; g < 4; ++g) { const int d0 = 32 * dt + 8 * g + 4 * hi; f32x4v nv;
#pragma unroll
                      for (int e = 0; e < 4; ++e) { const float el = ((const float*)(lds + EL))[d0 + e], fd = ((const float*)(lds + FD))[d0 + e];
                          const float sv = el * (vi == 0 ? S0[4 * g + e] : S1[4 * g + e]) + fd * acc[4 * g + e]; if (vi == 0) S0[4 * g + e] = sv; else S1[4 * g + e] = sv; nv[e] = sv; }
                      *(bf16x4*)(lds + STo + offST(32 * vt + r32, d0)) = __builtin_convertvector(nv, bf16x4); } } }
#pragma unroll
            for (int it = 0; it < 4; ++it) { const int t = it * 16 + wid * 2 + hi; const float4 x = *(const float4*)(lds + R0 + t * 512 + r32 * 16);
                float ss = x.x * x.x + x.y * x.y + x.z * x.z + x.w * x.w;
                ss += dppmov<0xB1>(ss); ss += dppmov<0x4E>(ss); ss += dppmov<0x141>(ss); ss += dppmov<0x140>(ss); { float a_ = ss, b_ = ss; swap16(a_, b_); ss = a_ + b_; }
                const float rs = rsqrtf(ss * (1.f / 128.f) + EPS);
                const float4 ng = ngv;
                const h16x2 ga = __builtin_bit_cast(h16x2, gq0[it]), gb = __builtin_bit_cast(h16x2, gq1[it]);
                const float g0 = (float)ga[0], g1 = (float)ga[1], g2 = (float)gb[0], g3 = (float)gb[1];
                uint2 w; w.x = pkh(x.x * rs * ng.x * g0 * sigmoidf_(g0), x.y * rs * ng.y * g1 * sigmoidf_(g1)); w.y = pkh(x.z * rs * ng.z * g2 * sigmoidf_(g2), x.w * rs * ng.w * g3 * sigmoidf_(g3));
                *(uint2*)(MIX + (tok0 + t) * D + 512 + hd * 128 + r32 * 4) = w; }
            HG_BAR();
        }
    }
}
struct XInfo { int rank, nloc, vx, nx; };
__device__ __forceinline__ XInfo xinfo_get(const XcdBarrier& xb) {
    volatile LAS unsigned* st = xb.st;
    __syncthreads();
    if (threadIdx.x == 0) { unsigned vx = 0; for (unsigned j = 0; j < 16; ++j) { const unsigned c = xb_ld(&xb.bar[XB_XCNT(j)]); if (j < xb.x && c > 0u) ++vx; } st[3] = vx; }
    __syncthreads();
    XInfo xi; xi.nloc = (int)st[0]; xi.nx = (int)st[1]; xi.rank = (int)st[2]; xi.vx = (int)st[3];
    if (xi.nloc < 1) xi.nloc = 1;
    if (xi.nx < 1) xi.nx = 1;
    return xi;
}
typedef unsigned u32x4g __attribute__((ext_vector_type(4)));
constexpr size_t WS_PART = WS_PROJ;
constexpr size_t WS_SSQ = 608 * MiB;
template <int CTRL> __device__ __forceinline__ int dppmovi(int v) { return __builtin_amdgcn_mov_dpp(v, CTRL, 0xf, 0xf, true); }
__device__ __forceinline__ void ph_g1(const P& p, const XInfo xi) {
    const unsigned char* HN8 = p.ws + WS_HN8; const unsigned char* U8 = p.ws + WS_U; const unsigned* SEL = (const unsigned*)(p.ws + WS_SELI); h16* PART = (h16*)(p.ws + WS_PART);
    const int tid = otid(), lane = tid & 63, wid = __builtin_amdgcn_readfirstlane(tid >> 6), rg = lane >> 3, seg = lane & 7;
    const int widx = xi.rank * NWAVE + wid, nwx = xi.nloc * NWAVE;
    for (int c = xi.vx; c < 8; c += xi.nx) {
        const unsigned char* Uc = U8 + (size_t)c * (16384 * 128) + seg * 16;
        u32x4g sl[4], uA[16], uB[16], xA, xB;
#define G1_SEL(TT) do { const u32x4g* sp_ = (const u32x4g*)(SEL + (size_t)(TT) * 128 + rg * 16); sl[0] = sp_[0]; sl[1] = sp_[1]; sl[2] = sp_[2]; sl[3] = sp_[3]; } while (0)
#define G1_ROWS(UU, XX, TT) do { _Pragma("unroll") for (int g = 0; g < 16; ++g) UU[g] = *(const u32x4g*)(Uc + (size_t)(sl[g >> 2][g & 3] >> 16) * 128); \
            XX = *(const u32x4g*)(HN8 + (size_t)(TT) * D + c * 128 + seg * 16); } while (0)
#define G1_COMP(UU, XX, TT) do { float dp[16]; \
            _Pragma("unroll") for (int g = 0; g < 16; ++g) { int a = 0; const u32x4g uw = UU[g]; \
                _Pragma("unroll") for (int i = 0; i < 4; ++i) a = __builtin_amdgcn_sdot4((int)XX[i], (int)uw[i], a, false); \
                a += dppmovi<0xB1>(a); a += dppmovi<0x4E>(a); a += dppmovi<0x141>(a); dp[g] = (float)a * (1.f / 6144.f); } \
            if (seg == 0) { u32x4g w0, w1; w0[0] = pkh(dp[0], dp[1]); w0[1] = pkh(dp[2], dp[3]); w0[2] = pkh(dp[4], dp[5]); w0[3] = pkh(dp[6], dp[7]); \
                w1[0] = pkh(dp[8], dp[9]); w1[1] = pkh(dp[10], dp[11]); w1[2] = pkh(dp[12], dp[13]); w1[3] = pkh(dp[14], dp[15]); \
                u32x4g* dst_ = (u32x4g*)(PART + ((size_t)c * T + (TT)) * 128 + rg * 16); dst_[0] = w0; dst_[1] = w1; } } while (0)
        int t = widx;
        if (t < T) { G1_SEL(t); G1_ROWS(uA, xA, t); if (t + nwx < T) G1_SEL(t + nwx); }
#pragma unroll 1
        for (; t < T; t += 2 * nwx) {
            const int t1 = t + nwx, t2 = t + 2 * nwx, t3 = t + 3 * nwx;
            if (t1 < T) { G1_ROWS(uB, xB, t1); if (t2 < T) G1_SEL(t2); }
            G1_COMP(uA, xA, t);
            if (t1 < T) {
                if (t2 < T) { G1_ROWS(uA, xA, t2); if (t3 < T) G1_SEL(t3); }
                G1_COMP(uB, xB, t1);
            }
        }
#undef G1_SEL
#undef G1_ROWS
#undef G1_COMP
    }
}
constexpr size_t WS_WQ8 = 608 * MiB + 4 * MiB;
__device__ __forceinline__ float wave_max_fast(float s) {
    s = fmaxf(s, dppmov<0xB1>(s)); s = fmaxf(s, dppmov<0x4E>(s)); s = fmaxf(s, dppmov<0x141>(s)); s = fmaxf(s, dppmov<0x140>(s));
    { float a = s, b = s; swap16(a, b); s = fmaxf(a, b); }
    { float a = s, b = s; swap32(a, b); s = fmaxf(a, b); }
    return s;
}
__device__ __forceinline__ void ph_g2(const P& p) {
    const h16* PART = (const h16*)(p.ws + WS_PART); unsigned* SEL = (unsigned*)(p.ws + WS_SELI); float* WQ = (float*)(p.ws + WS_WQ8); const float* SS = (const float*)(p.ws + WS_SS);
    const int lane = otid() & 63; const int gw = (blockIdx.x * blockDim.x + otid()) >> 6, nw = (gridDim.x * blockDim.x) >> 6;
    for (int t0 = gw; t0 < T; t0 += 2 * nw) {
        unsigned praw[2][8]; uint2 wsel[2]; float ssv[2];
#pragma unroll
        for (int u = 0; u < 2; ++u) { const int t = t0 + u * nw; if (t < T) {
#pragma unroll
            for (int c = 0; c < 8; ++c) praw[u][c] = *(const unsigned*)(PART + ((size_t)c * T + t) * 128 + lane * 2);
            wsel[u] = *(const uint2*)(SEL + (size_t)t * 128 + lane * 2); ssv[u] = SS[t]; } }
#pragma unroll
        for (int u = 0; u < 2; ++u) { const int t = t0 + u * nw; if (t < T) {
            float s0 = 0.f, s1 = 0.f;
#pragma unroll
            for (int c = 0; c < 8; ++c) { const h16x2 v = __builtin_bit_cast(h16x2, praw[u][c]); s0 += (float)v[0]; s1 += (float)v[1]; }
            { const float rt = rsqrtf(ssv[u] * (1.f / D) + EPS); s0 *= rt; s1 *= rt; }
            uint2 w = wsel[u];
            const float a0 = 0.5f * s0 * (1.f + erff(s0 * 0.70710678118654752f)), a1 = 0.5f * s1 * (1.f + erff(s1 * 0.70710678118654752f));
            const float w0 = (float)__builtin_bit_cast(h16, (unsigned short)(w.x & 0xffffu)) * a0, w1 = (float)__builtin_bit_cast(h16, (unsigned short)(w.y & 0xffffu)) * a1;
            const float mx = fmaxf(wave_max_fast(fmaxf(fabsf(w0), fabsf(w1))), 1e-30f); const float sc = 127.f / mx;
            w.x = (w.x & 0xffff0000u) | q8(w0 * sc); w.y = (w.y & 0xffff0000u) | q8(w1 * sc);
            *(uint2*)(SEL + (size_t)t * 128 + lane * 2) = w;
            if (lane == 0) WQ[t] = mx * (1.f / 127.f); } }
    }
}
__device__ __forceinline__ void swap32i(int& a, int& b) { auto r = __builtin_amdgcn_permlane32_swap((unsigned)a, (unsigned)b, false, false); unsigned r0 = r[0], r1 = r[1]; asm volatile("" : "+v"(r0), "+v"(r1)); a = (int)r0; b = (int)r1; }
__device__ __forceinline__ void swap16i(int& a, int& b) { auto r = __builtin_amdgcn_permlane16_swap((unsigned)a, (unsigned)b, false, false); unsigned r0 = r[0], r1 = r[1]; asm volatile("" : "+v"(r0), "+v"(r1)); a = (int)r0; b = (int)r1; }
__device__ __forceinline__ void ph_g3(const P& p, const XInfo xi) {
    const unsigned char* V8 = p.ws + WS_V; const unsigned* SEL = (const unsigned*)(p.ws + WS_SELI); h16* AC = (h16*)(p.ws + WS_XN); const float* WQ = (const float*)(p.ws + WS_WQ8);
    const int tid = otid(), lane = tid & 63, wid = __builtin_amdgcn_readfirstlane(tid >> 6), rg = lane >> 3, seg = lane & 7;
    const int widx = xi.rank * NWAVE + wid, nwx = xi.nloc * NWAVE;
    for (int c = xi.vx; c < 8; c += xi.nx) {
        const unsigned char* Vc = V8 + (size_t)c * (16384 * 128) + seg * 16;
        u32x4g sl[4], vA[16], vB[16]; unsigned wpA[4], wpB[4]; float dA, dB;
#define G3_SEL(TT) do { const u32x4g* sp_ = (const u32x4g*)(SEL + (size_t)(TT) * 128 + rg * 16); sl[0] = sp_[0]; sl[1] = sp_[1]; sl[2] = sp_[2]; sl[3] = sp_[3]; } while (0)
#define G3_ROWS(VV_, WP, DQ, TT) do { DQ = WQ[(TT)];  _Pragma("unroll") for (int q = 0; q < 4; ++q) { const unsigned p01 = __builtin_amdgcn_perm(sl[q][1], sl[q][0], 0x0c0c0400u), p23 = __builtin_amdgcn_perm(sl[q][3], sl[q][2], 0x04000c0cu); WP[q] = p01 | p23; } \
            _Pragma("unroll") for (int g = 0; g < 16; ++g) VV_[g] = *(const u32x4g*)(Vc + (size_t)(sl[g >> 2][g & 3] >> 16) * 128); } while (0)
#define G3_COMP(VV_, WP, DQ, TT) do { int acc[16]; \
            _Pragma("unroll") for (int i = 0; i < 16; ++i) acc[i] = 0; \
            _Pragma("unroll") for (int k = 0; k < 4; ++k) { \
                _Pragma("unroll") for (int i = 0; i < 4; ++i) { const unsigned r0 = VV_[4 * k][i], r1 = VV_[4 * k + 1][i], r2 = VV_[4 * k + 2][i], r3 = VV_[4 * k + 3][i]; \
                    const unsigned a01l = __builtin_amdgcn_perm(r1, r0, 0x05010400u), a01h = __builtin_amdgcn_perm(r1, r0, 0x07030602u), a23l = __builtin_amdgcn_perm(r3, r2, 0x05010400u), a23h = __builtin_amdgcn_perm(r3, r2, 0x07030602u); \
                    acc[4 * i]     = __builtin_amdgcn_sdot4((int)__builtin_amdgcn_perm(a23l, a01l, 0x05040100u), (int)WP[k], acc[4 * i], false); \
                    acc[4 * i + 1] = __builtin_amdgcn_sdot4((int)__builtin_amdgcn_perm(a23l, a01l, 0x07060302u), (int)WP[k], acc[4 * i + 1], false); \
                    acc[4 * i + 2] = __builtin_amdgcn_sdot4((int)__builtin_amdgcn_perm(a23h, a01h, 0x05040100u), (int)WP[k], acc[4 * i + 2], false); \
                    acc[4 * i + 3] = __builtin_amdgcn_sdot4((int)__builtin_amdgcn_perm(a23h, a01h, 0x07060302u), (int)WP[k], acc[4 * i + 3], false); } } \
            int r8[8], r4[4]; \
            _Pragma("unroll") for (int i = 0; i < 8; ++i) { int a = acc[i], b = acc[i + 8]; swap32i(a, b); r8[i] = a + b; } \
            _Pragma("unroll") for (int i = 0; i < 4; ++i) { int a = r8[i], b = r8[i + 4]; swap16i(a, b); r4[i] = a + b; } \
            const bool b3_ = (lane >> 3) & 1; int q0, q1; \
            { const int give = b3_ ? r4[0] : r4[2], keep = b3_ ? r4[2] : r4[0]; q0 = keep + dppmovi<0x128>(give); } \
            { const int give = b3_ ? r4[1] : r4[3], keep = b3_ ? r4[3] : r4[1]; q1 = keep + dppmovi<0x128>(give); } \
            const float dq_ = DQ * (1.f / 128.f); \
            *(unsigned*)(AC + (size_t)(TT) * D + c * 128 + seg * 16 + 2 * rg) = pkh((float)q0 * dq_, (float)q1 * dq_); } while (0)
        int t = widx;
        if (t < T) { G3_SEL(t); G3_ROWS(vA, wpA, dA, t); if (t + nwx < T) G3_SEL(t + nwx); }
#pragma unroll 1
        for (; t < T; t += 2 * nwx) {
            const int t1 = t + nwx, t2 = t + 2 * nwx, t3 = t + 3 * nwx;
            if (t1 < T) { G3_ROWS(vB, wpB, dB, t1); if (t2 < T) G3_SEL(t2); }
            G3_COMP(vA, wpA, dA, t);
            if (t1 < T) {
                if (t2 < T) { G3_ROWS(vA, wpA, dA, t2); if (t3 < T) G3_SEL(t3); }
                G3_COMP(vB, wpB, dB, t1);
            }
        }
#undef G3_SEL
#undef G3_ROWS
#undef G3_COMP
    }
}
__device__ __forceinline__ void ph_g4(const P& p) {
    float* O = p.out; const h16* H16 = (const h16*)(p.ws + WS_H16); const float* gf = p.gf; const h16* AC = (const h16*)(p.ws + WS_XN);
    const int lane = otid() & 63; const int gw = (blockIdx.x * blockDim.x + otid()) >> 6, nw = (gridDim.x * blockDim.x) >> 6;
    float4 gg[4];
#pragma unroll
    for (int j = 0; j < 4; ++j) gg[j] = *(const float4*)(gf + (lane + 64 * j) * 4);
    for (int t0 = gw; t0 < T; t0 += 2 * nw) {
        uint2 hraw[2][4], araw[2][4];
#pragma unroll
        for (int u = 0; u < 2; ++u) { const int t = t0 + u * nw; if (t < T) {
#pragma unroll
            for (int j = 0; j < 4; ++j) { hraw[u][j] = *(const uint2*)(H16 + (size_t)t * D + (lane + 64 * j) * 4); araw[u][j] = *(const uint2*)(AC + (size_t)t * D + (lane + 64 * j) * 4); } } }
#pragma unroll
        for (int u = 0; u < 2; ++u) { const int t = t0 + u * nw; if (t < T) {
            float4 o[4]; float ss = 0.f;
#pragma unroll
            for (int j = 0; j < 4; ++j) { const h16x2 h0 = __builtin_bit_cast(h16x2, hraw[u][j].x), h1 = __builtin_bit_cast(h16x2, hraw[u][j].y), a0 = __builtin_bit_cast(h16x2, araw[u][j].x), a1 = __builtin_bit_cast(h16x2, araw[u][j].y);
                o[j] = make_float4((float)h0[0] + (float)a0[0], (float)h0[1] + (float)a0[1], (float)h1[0] + (float)a1[0], (float)h1[1] + (float)a1[1]);
                ss += o[j].x * o[j].x + o[j].y * o[j].y + o[j].z * o[j].z + o[j].w * o[j].w; }
            const float r = rsqrtf(wave_sum_fast(ss) * (1.f / D) + EPS);
            float4* dst = (float4*)(O + (size_t)t * D);
#pragma unroll
            for (int j = 0; j < 4; ++j) dst[lane + 64 * j] = make_float4(o[j].x * r * gg[j].x, o[j].y * r * gg[j].y, o[j].z * r * gg[j].z, o[j].w * r * gg[j].w); } }
    }
}

__device__ __forceinline__ float vmax_(float a, float b) { float r; asm("v_max_f32_e32 %0, %1, %2" : "=v"(r) : "v"(a), "v"(b)); return r; }
__device__ __forceinline__ float vmin_(float a, float b) { float r; asm("v_min_f32_e32 %0, %1, %2" : "=v"(r) : "v"(a), "v"(b)); return r; }
__device__ __forceinline__ void ce_(float& a, float& b) { const float hi_ = vmax_(a, b), lo_ = vmin_(a, b); a = hi_; b = lo_; }
__device__ __forceinline__ void sort16(float (&v)[16]) {
#pragma unroll
    for (int p = 1; p < 16; p <<= 1)
#pragma unroll
        for (int k = p; k >= 1; k >>= 1)
#pragma unroll
            for (int j = k % p; j + k < 16; j += 2 * k)
#pragma unroll
                for (int i = 0; i < k; ++i)
                    if (i + j + k < 16 && (i + j) / (2 * p) == (i + j + k) / (2 * p)) ce_(v[i + j], v[i + j + k]);
}
__device__ __forceinline__ void merge_prune16(float (&a)[16], const float (&b)[16]) {
#pragma unroll
    for (int i = 0; i < 16; ++i) a[i] = vmax_(a[i], b[15 - i]);
#pragma unroll
    for (int s = 8; s >= 1; s >>= 1)
#pragma unroll
        for (int i = 0; i < 16; ++i) if ((i & s) == 0) ce_(a[i], a[i + s]);
}
__device__ __forceinline__ float mkc(float s, unsigned code) { return __builtin_bit_cast(float, (__builtin_bit_cast(unsigned, s) & ~255u) | code); }
__device__ __forceinline__ void ph_topk(const P& p, unsigned char* lds) {
    const h16* SC = (const h16*)(p.ws + WS_QP); unsigned* SEL = (unsigned*)(p.ws + WS_SELI);
    const int tid = otid(), lane = tid & 63, wid = __builtin_amdgcn_readfirstlane(tid >> 6), r32 = lane & 31, hi = lane >> 5;
    unsigned* scr = (unsigned*)(lds + wid * 4096);
    for (int tg = blockIdx.x; tg < T / 256; tg += gridDim.x) {
        const int tok = tg * 256 + wid * 32 + r32;
#pragma unroll 1
        for (int h = 0; h < PH; ++h) {
            float v1[16], v2[16];
#pragma unroll
            for (int c = 0; c < 2; ++c) {
                const h16x8* sp = (const h16x8*)(SC + (size_t)tok * QW + h * 256 + c * 128 + hi * 64);
                h16x8 raw[8];
#pragma unroll
                for (int q = 0; q < 8; ++q) raw[q] = sp[q];
                float g0[16], g1[16], g2[16], g3[16];
#pragma unroll
                for (int q = 0; q < 2; ++q)
#pragma unroll
                    for (int e = 0; e < 8; ++e) { const unsigned n = (unsigned)(hi * 64 + q * 8 + e);
                        g0[q * 8 + e] = __builtin_bit_cast(float, __builtin_bit_cast(unsigned, (float)raw[q][e]) | n);
                        g1[q * 8 + e] = __builtin_bit_cast(float, __builtin_bit_cast(unsigned, (float)raw[2 + q][e]) | (n + 16u));
                        g2[q * 8 + e] = __builtin_bit_cast(float, __builtin_bit_cast(unsigned, (float)raw[4 + q][e]) | (n + 32u));
                        g3[q * 8 + e] = __builtin_bit_cast(float, __builtin_bit_cast(unsigned, (float)raw[6 + q][e]) | (n + 48u)); }
                sort16(g0); sort16(g1); sort16(g2); sort16(g3);
                merge_prune16(g0, g1); merge_prune16(g2, g3); merge_prune16(g0, g2);
                float pr[16];
#pragma unroll
                for (int i = 0; i < 16; ++i) pr[i] = __shfl_xor(g0[i], 32);
                merge_prune16(g0, pr);
#pragma unroll
                for (int i = 0; i < 16; ++i) { if (c == 0) v1[i] = g0[i]; else v2[i] = g0[i]; }
            }
            if (hi == 0) {
#pragma unroll
                for (int i = 0; i < 16; ++i) { scr[i * 32 + r32] = __builtin_bit_cast(unsigned, v1[i]); scr[(16 + i) * 32 + r32] = __builtin_bit_cast(unsigned, v2[i]); } }
            float q0[16], q1[16], q2[16];
            q0[0] = mkc(v1[0] + v2[0], 0x00u);
            q0[1] = mkc(v1[0] + v2[1], 0x01u);
            q0[2] = mkc(v1[0] + v2[2], 0x02u);
            q0[3] = mkc(v1[0] + v2[3], 0x03u);
            q0[4] = mkc(v1[0] + v2[4], 0x04u);
            q0[5] = mkc(v1[0] + v2[5], 0x05u);
            q0[6] = mkc(v1[0] + v2[6], 0x06u);
            q0[7] = mkc(v1[0] + v2[7], 0x07u);
            q0[8] = mkc(v1[0] + v2[8], 0x08u);
            q0[9] = mkc(v1[0] + v2[9], 0x09u);
            q0[10] = mkc(v1[0] + v2[10], 0x0au);
            q0[11] = mkc(v1[0] + v2[11], 0x0bu);
            q0[12] = mkc(v1[0] + v2[12], 0x0cu);
            q0[13] = mkc(v1[0] + v2[13], 0x0du);
            q0[14] = mkc(v1[0] + v2[14], 0x0eu);
            q0[15] = mkc(v1[1] + v2[0], 0x10u);
            q1[0] = mkc(v1[1] + v2[1], 0x11u);
            q1[1] = mkc(v1[1] + v2[2], 0x12u);
            q1[2] = mkc(v1[1] + v2[3], 0x13u);
            q1[3] = mkc(v1[1] + v2[4], 0x14u);
            q1[4] = mkc(v1[1] + v2[5], 0x15u);
            q1[5] = mkc(v1[1] + v2[6], 0x16u);
            q1[6] = mkc(v1[1] + v2[7], 0x17u);
            q1[7] = mkc(v1[2] + v2[0], 0x20u);
            q1[8] = mkc(v1[2] + v2[1], 0x21u);
            q1[9] = mkc(v1[2] + v2[2], 0x22u);
            q1[10] = mkc(v1[2] + v2[3], 0x23u);
            q1[11] = mkc(v1[2] + v2[4], 0x24u);
            q1[12] = mkc(v1[3] + v2[0], 0x30u);
            q1[13] = mkc(v1[3] + v2[1], 0x31u);
            q1[14] = mkc(v1[3] + v2[2], 0x32u);
            q1[15] = mkc(v1[3] + v2[3], 0x33u);
            q2[0] = mkc(v1[4] + v2[0], 0x40u);
            q2[1] = mkc(v1[4] + v2[1], 0x41u);
            q2[2] = mkc(v1[4] + v2[2], 0x42u);
            q2[3] = mkc(v1[5] + v2[0], 0x50u);
            q2[4] = mkc(v1[5] + v2[1], 0x51u);
            q2[5] = mkc(v1[6] + v2[0], 0x60u);
            q2[6] = mkc(v1[6] + v2[1], 0x61u);
            q2[7] = mkc(v1[7] + v2[0], 0x70u);
            q2[8] = mkc(v1[7] + v2[1], 0x71u);
            q2[9] = mkc(v1[8] + v2[0], 0x80u);
            q2[10] = mkc(v1[9] + v2[0], 0x90u);
            q2[11] = mkc(v1[10] + v2[0], 0xa0u);
            q2[12] = mkc(v1[11] + v2[0], 0xb0u);
            q2[13] = mkc(v1[12] + v2[0], 0xc0u);
            q2[14] = mkc(v1[13] + v2[0], 0xd0u);
            q2[15] = mkc(v1[14] + v2[0], 0xe0u);
            const float x1 = mkc(v1[15] + v2[0], 0xf0u), x2 = mkc(v1[0] + v2[15], 0x0fu);
            sort16(q0); sort16(q1); sort16(q2);
            merge_prune16(q0, q1); merge_prune16(q0, q2);
            q0[15] = vmax_(q0[15], x1); ce_(q0[14], q0[15]); q0[15] = vmax_(q0[15], x2);
            const float smax = v1[0] + v2[0];
            const unsigned hmask = 0u - (unsigned)hi;
            float ex[8]; unsigned eidx[8]; float psum = 0.f;
#pragma unroll
            for (int i = 0; i < 8; ++i) { const float mine = __builtin_bit_cast(float, (__builtin_bit_cast(unsigned, q0[i]) & ~hmask) | (__builtin_bit_cast(unsigned, q0[8 + i]) & hmask)); const unsigned code = __builtin_bit_cast(unsigned, mine) & 255u;
                const unsigned n1 = scr[(code >> 4) * 32 + r32] & 127u, n2 = scr[(16 + (code & 15u)) * 32 + r32] & 127u;
                eidx[i] = n1 * 128u + n2; ex[i] = __builtin_amdgcn_exp2f((mine - smax) * 1.4426950408889634f); psum += ex[i]; }
            const float inv = 1.f / (psum + __shfl_xor(psum, 32));
            unsigned wout[8];
#pragma unroll
            for (int i = 0; i < 8; ++i) { const h16 gh = (h16)(ex[i] * inv); wout[i] = (eidx[i] << 16) | (unsigned)__builtin_bit_cast(unsigned short, gh); }
            uint4* dst = (uint4*)(SEL + ((size_t)tok * PH + h) * 16 + hi * 8);
            dst[0] = make_uint4(wout[0], wout[1], wout[2], wout[3]); dst[1] = make_uint4(wout[4], wout[5], wout[6], wout[7]);
        }
    }
}
constexpr int LDS_BYTES = 147456;
__global__ void __launch_bounds__(NTHR, 2) mk_fwd(P p) {
    extern __shared__ __attribute__((aligned(16))) unsigned char lds[];
    cg::grid_group grid = cg::this_grid();
    PG8_LAS unsigned char* lds3 = (PG8_LAS unsigned char*)lds;
    volatile LAS unsigned* xst = (volatile LAS unsigned*)(lds3 + LDS_BYTES - 16);
    if (threadIdx.x < 4) xst[threadIdx.x] = 0u;
    __syncthreads();
    const XcdBarrier xb = xcd_barrier_post((unsigned*)p.ws, xst);
    ph_prep(p, lds);
    grid.sync();
    {
        pg8::Gemm g{(const pg8::bf16_t*)(p.ws + WS_XN), (const pg8::bf16_t*)(p.ws + WS_WIN), T, INC, D}; pg8::StaticOrder So; So.init(T, INC, gridDim.x, blockIdx.x);
        pg8::EpiProj E{(pg8::bf16_t*)(p.ws + WS_PROJ), INC, (float*)(p.ws + WS_KM)};
        pg8::gemm_phase<pg8::EpiProj, pg8::StaticOrder, true, true>(lds3, g, So, E);
    }
    xcd_barrier(xb);
    ph_hgrn(p, lds);
    __syncthreads();
    ph_attn(p, lds);
    xcd_barrier(xb);
    {
        pg8::Gemm g{(const pg8::bf16_t*)(p.ws + WS_XN), (const pg8::bf16_t*)(p.ws + WS_WOUT), T, D, D}; pg8::StaticOrder So; So.init(T, D, gridDim.x, blockIdx.x);
        pg8::EpiOut E{p.x, (pg8::bf16_t*)(p.ws + WS_H16), D, p.g2, (pg8::bf16_t*)(p.ws + WS_HN), p.ws + WS_HN8, (float*)(p.ws + WS_SS)};
        pg8::gemm_phase<pg8::EpiOut, pg8::StaticOrder, true, true>(lds3, g, So, E);
    }
    xcd_barrier(xb);
    {
        pg8::Gemm g{(const pg8::bf16_t*)(p.ws + WS_HN), (const pg8::bf16_t*)(p.ws + WS_WQ), T, QW, D}; pg8::StaticOrder So; So.init(T, QW, gridDim.x, blockIdx.x);
        pg8::EpiH16RS E{(pg8::bf16_t*)(p.ws + WS_QP), QW, (const float*)(p.ws + WS_SS)};
        pg8::gemm_phase<pg8::EpiH16RS, pg8::StaticOrder, true, true>(lds3, g, So, E);
    }
    xcd_barrier(xb);
    ph_topk(p, lds);
    xcd_barrier(xb);
    { const XInfo xi = xinfo_get(xb);
      ph_g1(p, xi);
      xcd_barrier(xb);
      ph_g2(p);
      xcd_barrier(xb);
      ph_g3(p, xi);
      xcd_barrier(xb);
      ph_g4(p); }
}

extern "C" void kernel_launch(void* const* d_in, const int* in_sizes, int n_in, void* d_out, int out_size, void* d_ws, size_t ws_size, hipStream_t stream) {
    static int grid = 0;
    if (grid == 0) {
        int dev = 0, cus = 0, per_cu = 0;
        (void)hipGetDevice(&dev); (void)hipDeviceGetAttribute(&cus, hipDeviceAttributeMultiprocessorCount, dev);
        (void)hipFuncSetAttribute((const void*)mk_fwd, hipFuncAttributeMaxDynamicSharedMemorySize, LDS_BYTES);
        (void)hipOccupancyMaxActiveBlocksPerMultiprocessor(&per_cu, (const void*)mk_fwd, NTHR, LDS_BYTES);
        if (per_cu < 1) { fprintf(stderr, "kernel_launch: occupancy query says %d blocks/CU\n", per_cu); per_cu = 1; }
        if (per_cu > 1) per_cu = 1;
        grid = cus * per_cu;
        if (ws_size < 928 * MiB) { fprintf(stderr, "kernel_launch: workspace too small (%zu)\n", ws_size); grid = -1; }
    }
    if (grid < 0) return;
    P p{};
    p.x = (const float*)d_in[0]; p.g1 = (const float*)d_in[1]; p.w_in = (const float*)d_in[2]; p.lb_logits = (const float*)d_in[3]; p.rec_g = (const float*)d_in[4];
    p.w_out = (const float*)d_in[5]; p.g2 = (const float*)d_in[6]; p.wq = (const float*)d_in[7]; p.subk = (const float*)d_in[8]; p.u = (const float*)d_in[9];
    p.v = (const float*)d_in[10]; p.gf = (const float*)d_in[11]; p.out = (float*)d_out; p.ws = (unsigned char*)d_ws;
    (void)hipMemsetAsync(d_ws, 0, 16384, stream);
    void* args[] = {&p};
    hipError_t e = hipLaunchCooperativeKernel((const void*)mk_fwd, dim3(grid), dim3(NTHR), args, LDS_BYTES, stream);
    if (e != hipSuccess) fprintf(stderr, "cooperative launch failed: %s (grid %d)\n", hipGetErrorString(e), grid);
}
```

```cpp
#include <hip/hip_runtime.h>
#include <hip/hip_cooperative_groups.h>
#include <cstdio>
#include <stdint.h>
#include <math.h>
namespace cg = cooperative_groups;

typedef _Float16 h16;
typedef _Float16 h16x8 __attribute__((ext_vector_type(8)));
typedef _Float16 h16x2 __attribute__((ext_vector_type(2)));
typedef float f32x2 __attribute__((ext_vector_type(2)));
typedef float f32x16 __attribute__((ext_vector_type(16)));

constexpr int D = 1024, NB_ = 32, S = 2048, T = NB_ * S;
constexpr int INC = 3584;
constexpr int C_QA = 0, C_KA = 512, C_VA = 1024, C_QR = 1536, C_FR = 2048, C_IR = 2560, C_GR = 3072;
constexpr int AH = 8;
constexpr int RH = 4;
constexpr int PH = 8, QW = 2048;
constexpr float EPS = 1e-6f;
constexpr int NTHR = 512, NWAVE = 8;

constexpr size_t MiB = 1ull << 20;
constexpr size_t WS_LB = 64 * 1024;
constexpr size_t WS_WIN = 2 * MiB;
constexpr size_t WS_WOUT = 10 * MiB;
constexpr size_t WS_WQ = 12 * MiB;
constexpr size_t WS_KM = 17 * MiB;
constexpr size_t WS_SS = 18 * MiB;
constexpr size_t WS_U = 32 * MiB;
constexpr size_t WS_V = 64 * MiB;
constexpr size_t WS_XN = 96 * MiB;
constexpr size_t WS_PROJ = 224 * MiB;
constexpr size_t WS_QP = 224 * MiB;
constexpr size_t WS_HN = 480 * MiB;
constexpr size_t WS_SELI = 672 * MiB;
constexpr size_t WS_H16 = 800 * MiB;
constexpr size_t WS_HN8 = 704 * MiB;

struct P {
    const float *x, *g1, *w_in, *lb_logits, *rec_g, *w_out, *g2, *wq, *subk, *u, *v, *gf;
    float* out;
    unsigned char* ws;
};

#define LAS __attribute__((address_space(3)))
__device__ __forceinline__ int otid() { int t = threadIdx.x; asm volatile("" : "+v"(t)); return t; }
__device__ __forceinline__ float wave_sum(float v) {
#pragma unroll
    for (int o = 1; o < 64; o <<= 1) v += __shfl_xor(v, o);
    return v;
}
__device__ __forceinline__ float wave_max(float v) {
#pragma unroll
    for (int o = 1; o < 64; o <<= 1) v = fmaxf(v, __shfl_xor(v, o));
    return v;
}
__device__ __forceinline__ float sigmoidf_(float x) { return __builtin_amdgcn_rcpf(1.f + __builtin_amdgcn_exp2f(x * -1.4426950408889634f)); }
__device__ __forceinline__ unsigned q8(float v) { const float r = fminf(fmaxf(rintf(v), -127.f), 127.f); return (unsigned)((int)r) & 0xffu; }
typedef __bf16 bf16x2v __attribute__((ext_vector_type(2)));
__device__ __forceinline__ unsigned pkb(float lo, float hi) { f32x2 v = {lo, hi}; bf16x2v h = __builtin_convertvector(v, bf16x2v); return __builtin_bit_cast(unsigned, h); }
__device__ __forceinline__ unsigned pkh(float lo, float hi) { f32x2 v = {lo, hi}; h16x2 h = __builtin_convertvector(v, h16x2); return __builtin_bit_cast(unsigned, h); }

namespace pg8 {
#define PG8_LAS __attribute__((address_space(3)))
typedef unsigned short bf16_t;
typedef _Float16 f16x8 __attribute__((ext_vector_type(8)));
typedef __bf16 bf16x8m __attribute__((ext_vector_type(8)));
typedef float f32x4 __attribute__((ext_vector_type(4)));
typedef unsigned u32x4 __attribute__((ext_vector_type(4)));
constexpr int BM = 256, BK = 64, HALF = 128, HTB = HALF * BK * 2  , STAGE_BYTES = 8 * HTB, NXCD = 8, WGM = 8;

__host__ __device__ __forceinline__ int lds_byte(int r, int c) { const int st = (r >> 4) * 2 + (c >> 5), rr = r & 15, cc = c & 31, ob = rr * 64 + cc * 2; return st * 1024 + (ob ^ (((ob >> 9) & 1) << 5)); }
__host__ __device__ __forceinline__ void stage_rc(int b, int& R, int& C) { const int st = b / 1024, sb = b % 1024, swz = sb ^ (((sb >> 9) & 1) << 5); R = (st >> 1) * 16 + swz / 64; C = (st & 1) * 32 + (swz % 64) / 2; }
__host__ __device__ __forceinline__ int perm32(int rho) { const int n = rho >> 4, i = rho & 15; return 8 * (i >> 2) + 4 * n + (i & 3); }

struct Unit { int pm, pn; };
struct Gemm { const bf16_t* A; const bf16_t* Bt; int M, N, K; };

struct StaticOrder {
    int nM, nN, nwg, G, c;
    __host__ __device__ void init(int M, int N, int G_, int c_) { nM = M / BM; nN = N / BM; nwg = nM * nN; G = G_; c = c_; }
    __host__ __device__ bool next(int i, Unit& u) const {
        const long L = (long)i * G + c; if (L >= nwg) return false;
        int wgid = (int)L; { const int q = nwg / NXCD, r = nwg % NXCD, xcd = wgid % NXCD, off = wgid / NXCD; wgid = (xcd < r ? xcd * (q + 1) : r * (q + 1) + (xcd - r) * q) + off; }
        const int nig = WGM * nN, gid = wgid / nig, fm = gid * WGM, gsz = (nM - fm) < WGM ? (nM - fm) : WGM;
        u.pm = fm + ((wgid % nig) % gsz); u.pn = (wgid % nig) / gsz; return true;
    }
    __device__ __forceinline__ void a_ready(const Unit&) const {}
    __device__ __forceinline__ void done(const Unit&) const {}
};

__device__ __forceinline__ void fl_xchg(u32x4& x0, u32x4& x1) {
    u32x4 a, b;
#pragma unroll
    for (int i = 0; i < 4; ++i) { unsigned p0 = x0[i], p1 = x1[i];
        a[i] = (unsigned)__builtin_amdgcn_update_dpp((int)p0, (int)p1, 0x128, 0xf, 0xc, false);
        b[i] = (unsigned)__builtin_amdgcn_update_dpp((int)p1, (int)p0, 0x128, 0xf, 0x3, false); }
    x0 = a; x1 = b;
}
__device__ __forceinline__ unsigned q8h(float v) { const float r = fminf(fmaxf(rintf(v), -127.f), 119.f); return (unsigned)((int)r) & 0xffu; }
struct EpiProj {
    static constexpr bool PERM = true, AFTER_DRAIN = false, ADJ = true;
    bf16_t* O; int ldc; float* KM;
    __device__ __forceinline__ void operator()(const f32x4 (&acc)[2][2][4][2], const Unit& u, int wr, int wc, int fr, int fq) const {
        const int row0 = u.pm * BM + wr * 64 + fr; const int colp = u.pn * BM + wc * 64 + fq * 8;
#pragma unroll
        for (int ai = 0; ai < 2; ++ai)
#pragma unroll
            for (int m = 0; m < 4; ++m) { bf16_t* rowp = O + (size_t)(row0 + ai * HALF + m * 16) * ldc + colp;
                u32x4 w[2];
#pragma unroll
                for (int bj = 0; bj < 2; ++bj) { const f32x4 v0 = acc[ai][bj][m][0], v1 = acc[ai][bj][m][1];
                    w[bj].x = pkh(v0[0], v0[1]); w[bj].y = pkh(v0[2], v0[3]); w[bj].z = pkh(v1[0], v1[1]); w[bj].w = pkh(v1[2], v1[3]); }
                __builtin_nontemporal_store(w[0], (u32x4*)(rowp)); __builtin_nontemporal_store(w[1], (u32x4*)(rowp + 32)); }
        if (u.pn == 2 || u.pn == 3) { const int col0 = u.pn * BM + wc * 64 + 8 * fq;
#pragma unroll
            for (int bj = 0; bj < 2; ++bj)
#pragma unroll
                for (int n = 0; n < 2; ++n)
#pragma unroll
                    for (int e = 0; e < 4; ++e) { float s = 0.f;
#pragma unroll
                        for (int ai = 0; ai < 2; ++ai)
#pragma unroll
                            for (int m = 0; m < 4; ++m) s += acc[ai][bj][m][n][e];
                        s += __builtin_bit_cast(float, __builtin_amdgcn_mov_dpp(__builtin_bit_cast(int, s), 0xB1, 0xf, 0xf, true));
                        s += __builtin_bit_cast(float, __builtin_amdgcn_mov_dpp(__builtin_bit_cast(int, s), 0x4E, 0xf, 0xf, true));
                        s += __builtin_bit_cast(float, __builtin_amdgcn_mov_dpp(__builtin_bit_cast(int, s), 0x141, 0xf, 0xf, true));
                        s += __builtin_bit_cast(float, __builtin_amdgcn_mov_dpp(__builtin_bit_cast(int, s), 0x140, 0xf, 0xf, true));
                        if (fr == 0) atomicAdd(KM + (size_t)u.pm * 512 + (col0 - 512) + bj * 32 + n * 4 + e, s); }
        }
    }
};
struct EpiProjI8 {
    static constexpr bool PERM = true, AFTER_DRAIN = false, ADJ = true, I8 = true;
    bf16_t* O; int ldc; float* KM;
    __device__ __forceinline__ void operator()(const f32x4 (&acc)[2][2][4][2], const Unit& u, int wr, int wc, int fr, int fq) const {
        typedef int i32x4e __attribute__((ext_vector_type(4))); constexpr float sc = 1.f / 32768.f;
        const int row0 = u.pm * BM + wr * 64 + fr; const int colp = u.pn * BM + wc * 64 + fq * 8;
#pragma unroll
        for (int ai = 0; ai < 2; ++ai)
#pragma unroll
            for (int m = 0; m < 4; ++m) { bf16_t* rowp = O + (size_t)(row0 + ai * HALF + m * 16) * ldc + colp;
                u32x4 w[2];
#pragma unroll
                for (int bj = 0; bj < 2; ++bj) {
                    const i32x4e i0 = __builtin_bit_cast(i32x4e, acc[ai][bj][m][0]), i1 = __builtin_bit_cast(i32x4e, acc[ai][bj][m][1]);
                    const float x0 = (float)i0[0] * sc, x1 = (float)i0[1] * sc, x2 = (float)i0[2] * sc, x3 = (float)i0[3] * sc, y0 = (float)i1[0] * sc, y1 = (float)i1[1] * sc, y2 = (float)i1[2] * sc, y3 = (float)i1[3] * sc;
                    w[bj].x = pkh(x0, x1); w[bj].y = pkh(x2, x3); w[bj].z = pkh(y0, y1); w[bj].w = pkh(y2, y3); }
                __builtin_nontemporal_store(w[0], (u32x4*)(rowp)); __builtin_nontemporal_store(w[1], (u32x4*)(rowp + 32)); }
        if (u.pn == 2 || u.pn == 3) { const int col0 = u.pn * BM + wc * 64 + 8 * fq;
#pragma unroll
            for (int bj = 0; bj < 2; ++bj)
#pragma unroll
                for (int n = 0; n < 2; ++n) { i32x4e si = {0, 0, 0, 0};
#pragma unroll
                    for (int ai = 0; ai < 2; ++ai)
#pragma unroll
                        for (int m = 0; m < 4; ++m) si += __builtin_bit_cast(i32x4e, acc[ai][bj][m][n]);
#pragma unroll
                    for (int e_ = 0; e_ < 4; ++e_) { int sx = si[e_]; asm volatile("" : "+v"(sx));
                        sx += __builtin_amdgcn_mov_dpp(sx, 0xB1, 0xf, 0xf, true); sx += __builtin_amdgcn_mov_dpp(sx, 0x4E, 0xf, 0xf, true); sx += __builtin_amdgcn_mov_dpp(sx, 0x141, 0xf, 0xf, true); sx += __builtin_amdgcn_mov_dpp(sx, 0x140, 0xf, 0xf, true);
                        if (fr == 0) atomicAdd(KM + (size_t)u.pm * 512 + (col0 - 512) + bj * 32 + n * 4 + e_, (float)sx * sc); } }
        }
    }
};
struct EpiOut {
    static constexpr bool PERM = true, AFTER_DRAIN = false, ADJ = false;
    const float* base; bf16_t* H16; int ldc; const float* g2; bf16_t* HN; unsigned char* HN8; float* SS;
    __device__ __forceinline__ void operator()(const f32x4 (&acc)[2][2][4][2], const Unit& u, int wr, int wc, int fr, int fq) const {
        const int row0 = u.pm * BM + wr * 64 + fr; const int col0 = u.pn * BM + wc * 32 + 8 * fq;
        f32x4 gv[2][2];
#pragma unroll
        for (int bj = 0; bj < 2; ++bj) { gv[bj][0] = *(const f32x4*)(g2 + col0 + bj * HALF); gv[bj][1] = *(const f32x4*)(g2 + col0 + bj * HALF + 4); }
#pragma unroll
        for (int ai = 0; ai < 2; ++ai)
#pragma unroll
            for (int m = 0; m < 4; ++m) { const int row = row0 + ai * HALF + m * 16; const size_t off = (size_t)row * ldc + col0; float ss = 0.f;
#pragma unroll
                for (int bj = 0; bj < 2; ++bj) {
                    const f32x4 h0 = *(const f32x4*)(base + off + bj * HALF) + acc[ai][bj][m][0], h1 = *(const f32x4*)(base + off + bj * HALF + 4) + acc[ai][bj][m][1];
                    { u32x4 hw; hw.x = pkh(h0[0], h0[1]); hw.y = pkh(h0[2], h0[3]); hw.z = pkh(h1[0], h1[1]); hw.w = pkh(h1[2], h1[3]); *(u32x4*)(H16 + off + bj * HALF) = hw; }
                    ss += (h0[0] * h0[0] + h0[1] * h0[1]) + (h0[2] * h0[2] + h0[3] * h0[3]) + (h1[0] * h1[0] + h1[1] * h1[1]) + (h1[2] * h1[2] + h1[3] * h1[3]);
                    const f32x4 a = h0 * gv[bj][0], c = h1 * gv[bj][1];

                    { uint2 qi_; qi_.x = q8h(a[0] * 24.f) | (q8h(a[1] * 24.f) << 8) | (q8h(a[2] * 24.f) << 16) | (q8h(a[3] * 24.f) << 24); qi_.y = q8h(c[0] * 24.f) | (q8h(c[1] * 24.f) << 8) | (q8h(c[2] * 24.f) << 16) | (q8h(c[3] * 24.f) << 24);
                      *(uint2*)((unsigned char*)HN + off + bj * HALF) = qi_; } }
                ss += __shfl_xor(ss, 16); ss += __shfl_xor(ss, 32);
                if (fq == 0) atomicAdd(SS + row, ss); }
    }
};
struct EpiI8RS {
    static constexpr bool PERM = true, AFTER_DRAIN = false, ADJ = true, I8 = true;
    bf16_t* O; int ldc; const float* SS;
    __device__ __forceinline__ void operator()(const f32x4 (&acc)[2][2][4][2], const Unit& u, int wr, int wc, int fr, int fq) const {
        const int row0 = u.pm * BM + wr * 64; const int colp = u.pn * BM + wc * 64 + fq * 8;
#pragma unroll
        for (int ai = 0; ai < 2; ++ai)
#pragma unroll
            for (int m = 0; m < 4; ++m) { const int rb = row0 + ai * HALF + m * 16; bf16_t* rowp = O + (size_t)(rb + fr) * ldc + colp;
                const float r = __builtin_amdgcn_rsqf(SS[rb + fr] * (1.f / 1024.f) + 1e-6f) * (1.f / 24576.f);
                u32x4 w[2];
#pragma unroll
                for (int bj = 0; bj < 2; ++bj) { typedef int i32x4e __attribute__((ext_vector_type(4)));
                    const i32x4e i0 = __builtin_bit_cast(i32x4e, acc[ai][bj][m][0]), i1 = __builtin_bit_cast(i32x4e, acc[ai][bj][m][1]);
                    const float x0 = (float)i0[0] * r, x1 = (float)i0[1] * r, x2 = (float)i0[2] * r, x3 = (float)i0[3] * r, y0 = (float)i1[0] * r, y1 = (float)i1[1] * r, y2 = (float)i1[2] * r, y3 = (float)i1[3] * r;
                    w[bj].x = pkh(x0, x1); w[bj].y = pkh(x2, x3); w[bj].z = pkh(y0, y1); w[bj].w = pkh(y2, y3); }
                __builtin_nontemporal_store(w[0], (u32x4*)(rowp)); __builtin_nontemporal_store(w[1], (u32x4*)(rowp + 32)); }
    }
};
struct EpiH16RS {
    static constexpr bool PERM = true, AFTER_DRAIN = false, ADJ = true;
    bf16_t* O; int ldc; const float* SS;
    __device__ __forceinline__ void operator()(const f32x4 (&acc)[2][2][4][2], const Unit& u, int wr, int wc, int fr, int fq) const {
        const int row0 = u.pm * BM + wr * 64; const int colp = u.pn * BM + wc * 64 + fq * 8;
#pragma unroll
        for (int ai = 0; ai < 2; ++ai)
#pragma unroll
            for (int m = 0; m < 4; ++m) { const int rb = row0 + ai * HALF + m * 16; bf16_t* rowp = O + (size_t)(rb + fr) * ldc + colp;
                const float r = __builtin_amdgcn_rsqf(SS[rb + fr] * (1.f / 1024.f) + 1e-6f);
                u32x4 w[2];
#pragma unroll
                for (int bj = 0; bj < 2; ++bj) { const f32x4 v0 = acc[ai][bj][m][0] * r, v1 = acc[ai][bj][m][1] * r;
                    w[bj].x = pkh(v0[0], v0[1]); w[bj].y = pkh(v0[2], v0[3]); w[bj].z = pkh(v1[0], v1[1]); w[bj].w = pkh(v1[2], v1[3]); }
                __builtin_nontemporal_store(w[0], (u32x4*)(rowp)); __builtin_nontemporal_store(w[1], (u32x4*)(rowp + 32)); }
    }
};
template <class E, class = void> struct epi_i8 { static constexpr bool v = false; };
template <class E> struct epi_i8<E, decltype((void)E::I8)> { static constexpr bool v = E::I8; };
template <class Epi> __device__ __forceinline__ f32x4 mma16(const f16x8& b, const f16x8& a, const f32x4& c) {
    if constexpr (epi_i8<Epi>::v) { typedef int i32x4m __attribute__((ext_vector_type(4)));
        return __builtin_bit_cast(f32x4, __builtin_amdgcn_mfma_i32_16x16x64_i8(__builtin_bit_cast(i32x4m, b), __builtin_bit_cast(i32x4m, a), __builtin_bit_cast(i32x4m, c), 0, 0, 0)); }
    else return __builtin_amdgcn_mfma_f32_16x16x32_f16(b, a, c, 0, 0, 0);
}
template <class Epi, class Sched, bool ALIGN_EPI = false, bool SP2 = false, bool BF16 = false>
__device__ __forceinline__ void gemm_phase(PG8_LAS unsigned char* lds, const Gemm g, const Sched& S, const Epi& E) {
    const int tid = otid(), wid = __builtin_amdgcn_readfirstlane(tid >> 6), lane = tid & 63, wr = wid >> 2, wc = wid & 3, fr = lane & 15, fq = lane >> 4;
    const int K = g.K, nt = K / BK;
    unsigned voffA[2], voffB[2];
#pragma unroll
    for (int i = 0; i < 2; ++i) { int R, C; stage_rc(tid * 16 + i * 8192, R, C); const int Rb = Epi::ADJ ? ((R >> 5) * 64 + perm32(R & 31)) : Epi::PERM ? ((R & ~31) + perm32(R & 31)) : R;
        voffA[i] = (unsigned)(R * K + C) * 2u; voffB[i] = (unsigned)(Rb * K + C) * 2u; }
    const size_t kstep = (size_t)(BK * 2);
    const size_t hstep = (size_t)HALF * K * 2;
    const size_t tstep = 2 * hstep;
    const size_t hstepB = Epi::ADJ ? (size_t)32 * K * 2 : hstep;
    const unsigned ldsw = (unsigned)wid * 1024u;
    const int aoff = lds_byte(wr * 64 + fr, fq * 8), boff = lds_byte(wc * 32 + fr, fq * 8);
#define PG8_SA(b, h) (((b) * 2 + (h)) * HTB)
#define PG8_SB(b, h) ((4 + (b) * 2 + (h)) * HTB)
#define PG8_STAGE(bufoff, gbase, voff) do { _Pragma("unroll") for (int _i = 0; _i < 2; ++_i) \
        __builtin_amdgcn_global_load_lds((const unsigned*)((const char*)(gbase) + (voff)[_i]), (PG8_LAS unsigned*)(lds + (bufoff) + ldsw + _i * 8192), 16, 0, 0); } while (0)
#define PG8_LDA(dst, b, h) do { _Pragma("unroll") for (int m = 0; m < 4; ++m) _Pragma("unroll") for (int k = 0; k < 2; ++k) dst[m][k] = *(const PG8_LAS f16x8*)(lds + PG8_SA(b, h) + aoff + m * 2048 + k * 1024); } while (0)
#define PG8_LDB(dst, b, h) do { _Pragma("unroll") for (int n = 0; n < 2; ++n) _Pragma("unroll") for (int k = 0; k < 2; ++k) dst[n][k] = *(const PG8_LAS f16x8*)(lds + PG8_SB(b, h) + boff + n * 2048 + k * 1024); } while (0)
#define PG8_MMA(ai, bj, At, Bt) do { __builtin_amdgcn_s_setprio(1); _Pragma("unroll") for (int m = 0; m < 4; ++m) _Pragma("unroll") for (int n = 0; n < 2; ++n) _Pragma("unroll") for (int k = 0; k < 2; ++k) \
        acc[ai][bj][m][n] = mma16<Epi>(Bt[n][k], At[m][k], acc[ai][bj][m][n]); __builtin_amdgcn_s_setprio(0); } while (0)
#define PG8_WAIT_V(n) asm volatile("s_waitcnt vmcnt(" #n ")" ::: "memory")
#define PG8_WAIT_L(n) asm volatile("s_waitcnt lgkmcnt(" #n ")" ::: "memory")
#define PG8_BAR __builtin_amdgcn_s_barrier()
#define PG8_SCHED __builtin_amdgcn_sched_barrier(0)
    Unit cur, nxt; int ui = 0;
    if (!S.next(0, cur)) return;
    f32x4 acc[2][2][4][2];
#pragma unroll
    for (int a = 0; a < 2; ++a)
#pragma unroll
        for (int b = 0; b < 2; ++b)
#pragma unroll
            for (int m = 0; m < 4; ++m)
#pragma unroll
                for (int n = 0; n < 2; ++n) acc[a][b][m][n] = (f32x4){0.f, 0.f, 0.f, 0.f};
    f16x8 At[4][2], B0[2][2], B1[2][2];
    const char* cA = (const char*)g.A + (size_t)cur.pm * tstep; const char* cB = (const char*)g.Bt + (size_t)cur.pn * tstep;
    S.a_ready(cur);
    if constexpr (SP2) {
        PG8_STAGE(PG8_SB(0, 0), cB, voffB); PG8_STAGE(PG8_SB(0, 1), cB + hstepB, voffB); PG8_STAGE(PG8_SA(0, 0), cA, voffA); PG8_STAGE(PG8_SA(0, 1), cA + hstep, voffA);
        if (wr == 1) PG8_BAR;
        PG8_WAIT_V(2); PG8_BAR;
        PG8_STAGE(PG8_SB(1, 0), cB + kstep, voffB); PG8_STAGE(PG8_SA(1, 0), cA + kstep, voffA); PG8_STAGE(PG8_SB(1, 1), cB + hstepB + kstep, voffB);
        PG8_WAIT_V(6); PG8_BAR;
    } else {
        PG8_STAGE(PG8_SB(0, 0), cB, voffB); PG8_STAGE(PG8_SA(0, 0), cA, voffA); PG8_STAGE(PG8_SB(0, 1), cB + hstepB, voffB); PG8_STAGE(PG8_SA(0, 1), cA + hstep, voffA);
        if (wr == 1) PG8_BAR;
        PG8_WAIT_V(4); PG8_BAR;
        PG8_STAGE(PG8_SB(1, 0), cB + kstep, voffB); PG8_STAGE(PG8_SA(1, 0), cA + kstep, voffA); PG8_STAGE(PG8_SB(1, 1), cB + hstepB + kstep, voffB);
        PG8_WAIT_V(6); PG8_BAR;
    }
    for (;;) {
        const bool has_next = S.next(ui + 1, nxt);
        const char* nA = has_next ? (const char*)g.A + (size_t)nxt.pm * tstep : cA; const char* nB = has_next ? (const char*)g.Bt + (size_t)nxt.pn * tstep : cB;
        for (int t = 0; t < nt; t += 2) {
            const bool last = (t == nt - 2);
            const char* a1 = cA + (size_t)(t + 1) * kstep;
            const char* a2 = last ? nA : cA + (size_t)(t + 2) * kstep; const char* b2 = last ? nB : cB + (size_t)(t + 2) * kstep;
            const char* a3 = a2 + kstep; const char* b3 = b2 + kstep;
            if (last && has_next) S.a_ready(nxt);
            if constexpr (SP2) {
            PG8_LDB(B0, 0, 0); PG8_LDB(B1, 0, 1); PG8_SCHED; PG8_LDA(At, 0, 0); PG8_STAGE(PG8_SA(1, 1), a1 + hstep, voffA);
            PG8_WAIT_V(8); PG8_WAIT_L(0); PG8_BAR; PG8_MMA(0, 0, At, B0); PG8_MMA(0, 1, At, B1); PG8_BAR; PG8_SCHED;
            PG8_LDA(At, 0, 1); PG8_STAGE(PG8_SB(0, 0), b2, voffB); PG8_STAGE(PG8_SB(0, 1), b2 + hstepB, voffB); PG8_STAGE(PG8_SA(0, 0), a2, voffA);
            PG8_WAIT_V(8); PG8_WAIT_L(0); PG8_BAR; PG8_MMA(1, 0, At, B0); PG8_MMA(1, 1, At, B1); PG8_BAR; PG8_SCHED;
            PG8_LDB(B0, 1, 0); PG8_LDB(B1, 1, 1); PG8_SCHED; PG8_LDA(At, 1, 0); PG8_STAGE(PG8_SA(0, 1), a2 + hstep, voffA);
            PG8_WAIT_V(8); PG8_WAIT_L(0); PG8_BAR; PG8_MMA(0, 0, At, B0); PG8_MMA(0, 1, At, B1); PG8_BAR; PG8_SCHED;
            PG8_LDA(At, 1, 1); PG8_STAGE(PG8_SB(1, 0), b3, voffB); PG8_STAGE(PG8_SB(1, 1), b3 + hstepB, voffB); PG8_STAGE(PG8_SA(1, 0), a3, voffA);
            PG8_WAIT_V(8); PG8_WAIT_L(0); PG8_BAR; PG8_MMA(1, 0, At, B0); PG8_MMA(1, 1, At, B1); PG8_BAR; PG8_SCHED;
            } else {
            PG8_LDB(B0, 0, 0); PG8_SCHED; PG8_LDA(At, 0, 0); PG8_STAGE(PG8_SA(1, 1), a1 + hstep, voffA);
            PG8_WAIT_L(8); PG8_BAR; PG8_WAIT_L(0); PG8_MMA(0, 0, At, B0); PG8_BAR; PG8_SCHED;
            PG8_LDB(B1, 0, 1); PG8_STAGE(PG8_SB(0, 0), b2, voffB);
            PG8_BAR; PG8_WAIT_L(0); PG8_MMA(0, 1, At, B1); PG8_BAR;
            PG8_LDA(At, 0, 1); PG8_STAGE(PG8_SA(0, 0), a2, voffA);
            PG8_BAR; PG8_WAIT_L(0); PG8_MMA(1, 0, At, B0); PG8_BAR; PG8_SCHED;
            PG8_STAGE(PG8_SB(0, 1), b2 + hstepB, voffB);
            PG8_WAIT_V(6); PG8_BAR; PG8_MMA(1, 1, At, B1); PG8_BAR;
            PG8_LDB(B0, 1, 0); PG8_SCHED; PG8_LDA(At, 1, 0); PG8_STAGE(PG8_SA(0, 1), a2 + hstep, voffA);
            PG8_WAIT_L(8); PG8_BAR; PG8_WAIT_L(0); PG8_MMA(0, 0, At, B0); PG8_BAR; PG8_SCHED;
            PG8_LDB(B1, 1, 1); PG8_STAGE(PG8_SB(1, 0), b3, voffB);
            PG8_BAR; PG8_WAIT_L(0); PG8_MMA(0, 1, At, B1); PG8_BAR;
            PG8_LDA(At, 1, 1); PG8_STAGE(PG8_SA(1, 0), a3, voffA);
            PG8_BAR; PG8_WAIT_L(0); PG8_MMA(1, 0, At, B0); PG8_BAR; PG8_SCHED;
            PG8_STAGE(PG8_SB(1, 1), b3 + hstepB, voffB);
            PG8_WAIT_V(6); PG8_BAR; PG8_MMA(1, 1, At, B1); PG8_BAR;
            }
        }
        if constexpr (ALIGN_EPI) { if (wr == 0) PG8_BAR; }
        if constexpr (!Epi::AFTER_DRAIN) { E(acc, cur, wr, wc, fr, fq); S.done(cur); }
        if (!has_next) break;
#pragma unroll
        for (int a = 0; a < 2; ++a)
#pragma unroll
            for (int b = 0; b < 2; ++b)
#pragma unroll
                for (int m = 0; m < 4; ++m)
#pragma unroll
                    for (int n = 0; n < 2; ++n) acc[a][b][m][n] = (f32x4){0.f, 0.f, 0.f, 0.f};
        cur = nxt; cA = nA; cB = nB; ++ui;
        if constexpr (ALIGN_EPI) { if (wr == 1) PG8_BAR; }
    }
    PG8_WAIT_V(0);
    if constexpr (!ALIGN_EPI) { if (wr == 0) PG8_BAR; }
    PG8_BAR;
    if constexpr (Epi::AFTER_DRAIN) { E.fused(acc, cur, wr, wc, fr, fq, lds, wid, lane); S.done(cur); }
#undef PG8_SA
#undef PG8_SB
#undef PG8_STAGE
#undef PG8_LDA
#undef PG8_LDB
#undef PG8_MMA
#undef PG8_WAIT_V
#undef PG8_WAIT_L
#undef PG8_BAR
#undef PG8_SCHED
}
}
#define XB_TMO      128
#define XB_XCNT(j)  (256  + 64 * (j))
#define XB_XSUB(j)  (1280 + 64 * (j))
#define XB_XGEN(j)  (2304 + 64 * (j))
#define XB_TOP      3328
#define XB_TOPGEN   3392
#define XCD_BAR_WORDS 3456
#define XB_SPIN_CAP (1u << 18)

__device__ __forceinline__ unsigned xb_ld(unsigned* p)              { return __hip_atomic_load(p, __ATOMIC_RELAXED, __HIP_MEMORY_SCOPE_AGENT); }
__device__ __forceinline__ unsigned xb_add(unsigned* p, unsigned v) { return __hip_atomic_fetch_add(p, v, __ATOMIC_RELAXED, __HIP_MEMORY_SCOPE_AGENT); }
__device__ __forceinline__ unsigned xb_xcc_id() { return (unsigned)__builtin_amdgcn_s_getreg((3 << 11) | 20) & 0xFu; }
#define XB_SPIN(cond, bar) do { unsigned _sp = 0; while (cond) { __builtin_amdgcn_s_sleep(1); \
    if ((++_sp & 255u) == 0u) { if (xb_ld(&(bar)[XB_TMO])) break; if (_sp > XB_SPIN_CAP) { atomicAdd(&(bar)[XB_TMO], 1u); break; } } } } while (0)

struct XcdBarrier {
    unsigned* bar; unsigned x;
    volatile LAS unsigned* st;
};

__device__ __forceinline__ XcdBarrier xcd_barrier_post(unsigned* bar, volatile LAS unsigned* st) {
    XcdBarrier b; b.bar = bar; b.x = xb_xcc_id(); b.st = st;
    if (threadIdx.x == 0) st[2] = xb_add(&bar[XB_XCNT(b.x)], 1u);
    return b;
}
__device__ __forceinline__ void xcd_barrier_complete(unsigned* bar, unsigned x, unsigned& nloc, unsigned& nx) {
    const unsigned G = gridDim.x * gridDim.y * gridDim.z;
    unsigned sum, cnt, mine, sp = 0u;
    for (;;) {
        sum = 0u; cnt = 0u; mine = 0u;
#pragma unroll
        for (unsigned j = 0; j < 16; ++j) { const unsigned c = xb_ld(&bar[XB_XCNT(j)]); sum += c; cnt += (c > 0u) ? 1u : 0u; mine = (j == x) ? c : mine; }
        if (sum == G) break;
        __builtin_amdgcn_s_sleep(1);
        if ((++sp & 255u) == 0u) { if (xb_ld(&bar[XB_TMO])) break; if (sp > XB_SPIN_CAP) { atomicAdd(&bar[XB_TMO], 1u); break; } }
    }
    nloc = mine > 0u ? mine : 1u; nx = cnt > 0u ? cnt : 1u;
}

__device__ __forceinline__ void xcd_barrier(const XcdBarrier& b) {
    asm volatile("s_waitcnt vmcnt(0)" ::: "memory");
    __syncthreads();
    if (threadIdx.x == 0) {
        unsigned* bar = b.bar;
        __builtin_amdgcn_s_waitcnt(0);
        unsigned nloc = b.st[0], nx = b.st[1];
        if (nloc == 0u) { xcd_barrier_complete(bar, b.x, nloc, nx); b.st[0] = nloc; b.st[1] = nx; }
        const unsigned old = xb_add(&bar[XB_XSUB(b.x)], 1u);
        const unsigned gen = old / nloc;
        if (old + 1u == (gen + 1u) * nloc) {
            __builtin_amdgcn_fence(__ATOMIC_RELEASE, "agent");
            asm volatile("s_waitcnt vmcnt(0)" ::: "memory");
            const unsigned og = xb_add(&bar[XB_TOP], 1u);
            const unsigned tg = og / nx;
            if (og + 1u == (tg + 1u) * nx) xb_add(&bar[XB_TOPGEN], 1u);
            else XB_SPIN(xb_ld(&bar[XB_TOPGEN]) == tg, bar);
            __builtin_amdgcn_fence(__ATOMIC_ACQUIRE, "agent");
            xb_add(&bar[XB_XGEN(b.x)], 1u);
            asm volatile("s_waitcnt vmcnt(0)" ::: "memory");
        } else {
            XB_SPIN(xb_ld(&bar[XB_XGEN(b.x)]) == gen, bar);
            __builtin_amdgcn_fence(__ATOMIC_ACQUIRE, "agent");
            asm volatile("s_waitcnt vmcnt(0)" ::: "memory");
        }
    }
    __syncthreads();
}

template <int CTRL> __device__ __forceinline__ float dppmov(float v) { return __builtin_bit_cast(float, __builtin_amdgcn_mov_dpp(__builtin_bit_cast(int, v), CTRL, 0xf, 0xf, true)); }
__device__ __forceinline__ void swap32(float& a, float& b) { auto r = __builtin_amdgcn_permlane32_swap(__builtin_bit_cast(unsigned, a), __builtin_bit_cast(unsigned, b), false, false); unsigned r0 = r[0], r1 = r[1]; asm volatile("" : "+v"(r0), "+v"(r1)); a = __builtin_bit_cast(float, r0); b = __builtin_bit_cast(float, r1); }
__device__ __forceinline__ void swap16(float& a, float& b) { auto r = __builtin_amdgcn_permlane16_swap(__builtin_bit_cast(unsigned, a), __builtin_bit_cast(unsigned, b), false, false); unsigned r0 = r[0], r1 = r[1]; asm volatile("" : "+v"(r0), "+v"(r1)); a = __builtin_bit_cast(float, r0); b = __builtin_bit_cast(float, r1); }
__device__ __forceinline__ float wave_sum_fast(float s) {
    s += dppmov<0xB1>(s); s += dppmov<0x4E>(s); s += dppmov<0x141>(s); s += dppmov<0x140>(s);
    { float a = s, b = s; swap16(a, b); s = a + b; }
    { float a = s, b = s; swap32(a, b); s = a + b; }
    return s;
}
template <bool FP8> __device__ __forceinline__ void rmsnorm_rows(const float* X, const float* g, h16* O, unsigned char* O8) {
    const int lane = otid() & 63; const int gw = (blockIdx.x * blockDim.x + otid()) >> 6, nw = (gridDim.x * blockDim.x) >> 6;
    float4 gg[4];
#pragma unroll
    for (int j = 0; j < 4; ++j) gg[j] = *(const float4*)(g + (lane + 64 * j) * 4);
    for (int t0 = gw; t0 < T; t0 += 2 * nw) {
        float4 v[2][4];
#pragma unroll
        for (int u = 0; u < 2; ++u) { const int t = t0 + u * nw; if (t < T) {
#pragma unroll
            for (int j = 0; j < 4; ++j) v[u][j] = ((const float4*)(X + (size_t)t * D))[lane + 64 * j]; } }
#pragma unroll
        for (int u = 0; u < 2; ++u) { const int t = t0 + u * nw; if (t < T) {
            float s = 0.f;
#pragma unroll
            for (int j = 0; j < 4; ++j) s += v[u][j].x * v[u][j].x + v[u][j].y * v[u][j].y + v[u][j].z * v[u][j].z + v[u][j].w * v[u][j].w;
            const float r = rsqrtf(wave_sum_fast(s) * (1.f / D) + EPS);
#pragma unroll
            for (int j = 0; j < 4; ++j) { const int cc = (lane + 64 * j) * 4;
                const float a0 = v[u][j].x * r * gg[j].x, a1 = v[u][j].y * r * gg[j].y, a2 = v[u][j].z * r * gg[j].z, a3 = v[u][j].w * r * gg[j].w;
                if (!FP8) { uint2 w; w.x = pkh(a0, a1); w.y = pkh(a2, a3); *(uint2*)(O + (size_t)t * D + cc) = w; }
                if (FP8) *(unsigned*)(O8 + (size_t)t * D + cc) = q8(a0 * 32.f) | (q8(a1 * 32.f) << 8) | (q8(a2 * 32.f) << 16) | (q8(a3 * 32.f) << 24); } } }
    }
}

__device__ __forceinline__ void prep_w2(const P& p) {
    h16* W2T = (h16*)(p.ws + WS_WQ);
    const int lane = otid() & 63, r32 = lane & 31, hi = lane >> 5; const int gw = (blockIdx.x * blockDim.x + otid()) >> 6, nw = (gridDim.x * blockDim.x) >> 6;
    for (int tile = gw; tile < 16 * 4 * 32; tile += nw) {
        const int hc = tile >> 7, nt = (tile >> 5) & 3, kt = tile & 31;
        const float* ap = p.subk + ((size_t)hc * 128 + 32 * nt + r32) * 128 + hi * 8;
        const float* bp = p.wq + (size_t)(32 * kt + r32) * QW + hc * 128 + hi * 8;
        f32x16 acc;
#pragma unroll
        for (int r = 0; r < 16; ++r) acc[r] = 0.f;
#pragma unroll
        for (int ks = 0; ks < 8; ++ks) {
            const float4 a0 = *(const float4*)(ap + ks * 16), a1 = *(const float4*)(ap + ks * 16 + 4), b0 = *(const float4*)(bp + ks * 16), b1 = *(const float4*)(bp + ks * 16 + 4);
            const h16x8 af = {(h16)a0.x, (h16)a0.y, (h16)a0.z, (h16)a0.w, (h16)a1.x, (h16)a1.y, (h16)a1.z, (h16)a1.w};
            const h16x8 bf = {(h16)b0.x, (h16)b0.y, (h16)b0.z, (h16)b0.w, (h16)b1.x, (h16)b1.y, (h16)b1.z, (h16)b1.w};
            acc = __builtin_amdgcn_mfma_f32_32x32x16_f16(af, bf, acc, 0, 0, 0); }
        signed char* op = (signed char*)W2T + ((size_t)hc * 128 + 32 * nt) * D + 32 * kt + r32;
#pragma unroll
        for (int r = 0; r < 16; ++r) op[(size_t)((r & 3) + 8 * (r >> 2) + 4 * hi) * D] = (signed char)(int)fminf(fmaxf(rintf(acc[r] * 1024.f), -127.f), 127.f);
    }
}

__device__ __forceinline__ void transpose_item(const float* W, int N, h16* WT, float* scr, int item, int lane, unsigned char* WT8 = nullptr) {
    const int nblk = N / 32, kb = item / nblk, nb = item % nblk, k0 = 64 * kb, n0 = 32 * nb;
#pragma unroll 8
    for (int i = 0; i < 32; ++i) { const int kk = 2 * i + (lane >> 5); scr[kk * 33 + (lane & 31)] = W[(size_t)(k0 + kk) * N + n0 + (lane & 31)]; }
    const int cch = lane & 7;
    if (WT8) {
#pragma unroll
        for (int j = 0; j < 4; ++j) { const int n = (lane >> 3) + 8 * j; const float* s = scr + (8 * cch) * 33 + n;
            uint2 o; o.x = q8(s[0 * 33] * 1024.f) | (q8(s[1 * 33] * 1024.f) << 8) | (q8(s[2 * 33] * 1024.f) << 16) | (q8(s[3 * 33] * 1024.f) << 24);
            o.y = q8(s[4 * 33] * 1024.f) | (q8(s[5 * 33] * 1024.f) << 8) | (q8(s[6 * 33] * 1024.f) << 16) | (q8(s[7 * 33] * 1024.f) << 24);
            *(uint2*)(WT8 + (size_t)(n0 + n) * D + k0 + 8 * cch) = o; }
        return; }
#pragma unroll
    for (int j = 0; j < 4; ++j) { const int n = (lane >> 3) + 8 * j; const float* s = scr + (8 * cch) * 33 + n;
        uint4 o; o.x = pkh(s[0 * 33], s[1 * 33]); o.y = pkh(s[2 * 33], s[3 * 33]); o.z = pkh(s[4 * 33], s[5 * 33]); o.w = pkh(s[6 * 33], s[7 * 33]);
        *(uint4*)(WT + (size_t)(n0 + n) * D + k0 + 8 * cch) = o; }
}
__device__ __forceinline__ unsigned q4n(float v) { const float r = fminf(fmaxf(rintf(v), -8.f), 7.f); return (unsigned)((int)r) & 0xfu; }
__device__ __forceinline__ unsigned q4o(float v) { const float r = fminf(fmaxf(rintf(v), -8.f), 7.f); return (unsigned)((int)r + 8) & 0xfu; }
__device__ __forceinline__ void table_item(const P& p, size_t i) {
    uint4 wu, wv; unsigned* pu = (unsigned*)&wu; unsigned* pv = (unsigned*)&wv;
#pragma unroll
    for (int w = 0; w < 4; ++w) { const float4 a0 = ((const float4*)p.u)[i * 8 + 2 * w], a1 = ((const float4*)p.u)[i * 8 + 2 * w + 1], b0 = ((const float4*)p.v)[i * 8 + 2 * w], b1 = ((const float4*)p.v)[i * 8 + 2 * w + 1];
        pu[w] = (q4n(a0.x * 96.f) | (q4n(a1.x * 96.f) << 4)) | ((q4n(a0.y * 96.f) | (q4n(a1.y * 96.f) << 4)) << 8) | ((q4n(a0.z * 96.f) | (q4n(a1.z * 96.f) << 4)) << 16) | ((q4n(a0.w * 96.f) | (q4n(a1.w * 96.f) << 4)) << 24);
        pv[w] = (q4o(b0.x * 32.f) | (q4n(b1.x * 32.f) << 4)) | ((q4o(b0.y * 32.f) | (q4n(b1.y * 32.f) << 4)) << 8) | ((q4o(b0.z * 32.f) | (q4n(b1.z * 32.f) << 4)) << 16) | ((q4o(b0.w * 32.f) | (q4n(b1.w * 32.f) << 4)) << 24); }
    const size_t e_ = i >> 5, ch = i & 31, so = (ch >> 3) * ((size_t)16384 * 128) + e_ * 128 + (ch & 7) * 16;
    *(uint4*)(p.ws + WS_U + so) = wu; *(uint4*)(p.ws + WS_V + so) = wv;
}
__device__ __forceinline__ void ph_prep(const P& p, unsigned char* lds) {
    h16* WinT = (h16*)(p.ws + WS_WIN); h16* WoutT = (h16*)(p.ws + WS_WOUT); float* LB = (float*)(p.ws + WS_LB);
    const size_t gid = (size_t)blockIdx.x * blockDim.x + otid(), gs = (size_t)gridDim.x * blockDim.x;
    for (size_t i = gid; i < (size_t)NB_ * 8 * 512; i += gs) ((float*)(p.ws + WS_KM))[i] = 0.f;
    for (size_t i = gid; i < (size_t)T; i += gs) ((float*)(p.ws + WS_SS))[i] = 0.f;
    for (size_t i = gid; i < 512; i += gs) { const float a = p.lb_logits[i], b = p.lb_logits[512 + i]; const float m = fmaxf(a, b); const float ea = __expf(a - m), eb = __expf(b - m); LB[i] = ea / (ea + eb); }
    { float* scr = (float*)(lds + (otid() >> 6) * 16384); const int lane_ = otid() & 63; const int gw_ = (blockIdx.x * blockDim.x + otid()) >> 6, nw_ = (gridDim.x * blockDim.x) >> 6;
      constexpr int I_IN = (D / 64) * (INC / 32), I_OUT = (D / 64) * (D / 32);
      for (int it = gw_; it < I_IN + I_OUT; it += nw_) { if (it < I_IN) transpose_item(p.w_in, INC, WinT, scr, it, lane_, (unsigned char*)WinT); else transpose_item(p.w_out, D, WoutT, scr, it - I_IN, lane_); } }
    prep_w2(p);
    rmsnorm_rows<true>(p.x, p.g1, (h16*)(p.ws + WS_XN), p.ws + WS_HN8);
}

typedef short v4i16_t __attribute__((ext_vector_type(4)));
typedef _Float16 h16x4 __attribute__((ext_vector_type(4)));
#define LAS3 __attribute__((address_space(3)))
__device__ __forceinline__ h16x4 tr16(const LAS3 unsigned char* p) { return __builtin_bit_cast(h16x4, __builtin_amdgcn_ds_read_tr16_b64_v4i16((LAS3 v4i16_t*)p)); }
__device__ __forceinline__ h16x8 pk8(const f32x16& v, int b) {
    typedef unsigned u32x4_t __attribute__((ext_vector_type(4)));
    u32x4_t w; w.x = pkh(v[b], v[b + 1]); w.y = pkh(v[b + 2], v[b + 3]); w.z = pkh(v[b + 4], v[b + 5]); w.w = pkh(v[b + 6], v[b + 7]);
    return __builtin_bit_cast(h16x8, w);
}
__device__ __forceinline__ void glds16(const void* g, unsigned ldsoff) {
    unsigned keep;
    asm volatile("s_mov_b32 %0, m0\n\ts_mov_b32 m0, %2\n\ts_nop 0\n\tglobal_load_lds_dwordx4 %1, off\n\ts_mov_b32 m0, %0" : "=&s"(keep) : "v"(g), "s"(ldsoff) : "memory");
}
__device__ __forceinline__ void ph_attn(const P& p, unsigned char* lds) {
    const h16* PROJ = (const h16*)(p.ws + WS_PROJ); const float* KM = (const float*)(p.ws + WS_KM); h16* MIX = (h16*)(p.ws + WS_XN);
    const int tid = otid(), lane = tid & 63, wid = __builtin_amdgcn_readfirstlane(tid >> 6), r32 = lane & 31, hi = lane >> 5;
    const LAS3 unsigned char* lds3 = (const LAS3 unsigned char*)lds; const unsigned ldsb = (unsigned)(__SIZE_TYPE__)(LAS3 unsigned char*)lds;
    float* wsf = (float*)(lds + 98304) + wid * 64;
    constexpr float C2 = 0.125f * 1.4426950408889634f;
    const int k_key = wid * 8 + (lane >> 3), k_c = (lane & 7) ^ (lane >> 3);
    const int v_key = (wid & 3) * 16 + (lane >> 2), v_col = (wid >> 2) * 32 + (lane & 3) * 8;
    const int vaddr = 16384 + ((lane >> 4) & 1) * 32 + (lane & 3) * 8 + (4 * hi + ((lane & 15) >> 2)) * 64;
    const int kaddr = r32 * 128;
    unsigned* qctr = (unsigned*)p.ws + 4000;
    volatile unsigned* qsl = (volatile unsigned*)(lds + 140032);
    if (wid >= 4) __builtin_amdgcn_s_setprio(1);
    for (;;) {
        asm volatile("s_waitcnt lgkmcnt(0)" ::: "memory"); __builtin_amdgcn_s_barrier(); asm volatile("" ::: "memory");
        if (tid == 0) qsl[0] = atomicAdd(qctr, 1u);
        asm volatile("s_waitcnt lgkmcnt(0)" ::: "memory"); __builtin_amdgcn_s_barrier(); asm volatile("" ::: "memory");
        const unsigned qi = __builtin_amdgcn_readfirstlane(qsl[0]);
        if (qi >= (unsigned)(NB_ * AH * 8 + 256)) break;
        if (qi % 9u == 8u) {
            const size_t ib = (size_t)(qi / 9u) * 2048 + tid;
#pragma unroll 2
            for (int it = 0; it < 4; ++it) table_item(p, ib + (size_t)it * 512);
            continue; }
        const unsigned unit = qi - qi / 9u;
        const int own = 7 - (int)(unit >> 8), bh = (int)(unit & 255u);
        {
        const int b = bh >> 3, h = bh & 7; const float sl2 = exp2f(-(float)(h + 1)) * 1.4426950408889634f;
        const h16* Kg = PROJ + (size_t)b * S * INC + C_KA + h * 64 + (size_t)k_key * INC + k_c * 8;
        const h16* Vg = PROJ + (size_t)b * S * INC + C_VA + h * 64 + (size_t)v_key * INC + v_col;
#define ATT_KB(t_) (((t_) < 4) ? own * 256 + (t_) * 64 : ((t_) - 4) * 64)
#define ATT_GLDS(pair_, st_) do { _Pragma("unroll") for (int s_ = 0; s_ < 2; ++s_) { const int kb_ = ATT_KB(2 * (pair_) + s_); \
            glds16(Kg + (size_t)kb_ * INC, ldsb + (st_) * 32768 + s_ * 8192 + wid * 1024); \
            glds16(Vg + (size_t)kb_ * INC, ldsb + (st_) * 32768 + 16384 + s_ * 8192 + wid * 1024); } } while (0)
        ATT_GLDS(0, 0); ATT_GLDS(1, 1);
            const int qrel = wid * 32 + r32, qpos = own * 256 + qrel;
            h16x8 qf[4];
            { const h16* qp = PROJ + (size_t)(b * S + qpos) * INC + C_QA + h * 64 + hi * 8;
#pragma unroll
              for (int ks = 0; ks < 4; ++ks) { const h16x8 raw = *(const h16x8*)(qp + ks * 16);
#pragma unroll
                  for (int e = 0; e < 8; ++e) qf[ks][e] = (h16)((float)raw[e] * C2); } }
            unsigned selbits = 0;
            if (tid < own * 64) ((float*)(lds + 137472))[tid] = KM[(size_t)(b * 8 + (tid >> 6)) * 512 + h * 64 + (tid & 63)];
            asm volatile("s_waitcnt lgkmcnt(0)" ::: "memory"); __builtin_amdgcn_s_barrier(); asm volatile("" ::: "memory");
            { float* gsc = (float*)(lds + 100352) + wid * 512 + lane;
              const float* kmz = (const float*)(lds + 137472);
#pragma unroll 1
              for (int j = 0; j < own; ++j) { float a = 0.f; const float* km = kmz + j * 64 + hi * 8;
#pragma unroll
                  for (int ks = 0; ks < 4; ++ks) { const float4 k0 = *(const float4*)(km + ks * 16), k1 = *(const float4*)(km + ks * 16 + 4);
                      a += (float)qf[ks][0] * k0.x + (float)qf[ks][1] * k0.y + (float)qf[ks][2] * k0.z + (float)qf[ks][3] * k0.w
                         + (float)qf[ks][4] * k1.x + (float)qf[ks][5] * k1.y + (float)qf[ks][6] * k1.z + (float)qf[ks][7] * k1.w; }
                  a += __shfl_xor(a, 32); gsc[j * 64] = a; }
              float g[8];
#pragma unroll
              for (int j = 0; j < 8; ++j) { const float a = gsc[j * 64]; g[j] = (j < own) ? a : -INFINITY; }
#pragma unroll
              for (int rnd = 0; rnd < 3; ++rnd) { float best = -INFINITY; int bi = -1;
#pragma unroll
                  for (int j = 0; j < 8; ++j) { const bool t_ = !((selbits >> j) & 1) && g[j] > best; best = t_ ? g[j] : best; bi = t_ ? j : bi; }
                  if (bi >= 0) selbits |= 1u << bi; } }
            float m_run = 0.f, l_run = 0.f; f32x16 o0, o1;
#pragma unroll
            for (int r = 0; r < 16; ++r) { o0[r] = 0.f; o1[r] = 0.f; }
            const int NP = 2 + 2 * own;
            int st = 0;
            for (int tp = 0; tp < NP; ++tp) {
                if (tp + 1 < NP) asm volatile("s_waitcnt vmcnt(4)" ::: "memory"); else asm volatile("s_waitcnt vmcnt(0)" ::: "memory");
                asm volatile("s_waitcnt lgkmcnt(0)" ::: "memory"); __builtin_amdgcn_s_barrier();
                if (tp + 2 < NP) { const int st2 = (st == 0) ? 2 : st - 1; ATT_GLDS(tp + 2, st2); }
                {
                const int t0 = 2 * tp; const int kb0 = ATT_KB(t0);
                bool need0, need1; float maskadd = 0.f;
                if (t0 < 4) { need0 = (t0 <= (wid >> 1)); need1 = (t0 + 1 <= (wid >> 1)); }
                else { const bool sel = (selbits >> ((t0 - 4) >> 2)) & 1; need0 = need1 = (__any(sel) != 0); maskadd = sel ? 0.f : -INFINITY; }
                if (need0) {
                    const int bo = st * 32768;
                    float sl2v = sl2; asm volatile("" : "+v"(sl2v));
                    const float base2 = -sl2v * (float)(qpos - kb0) + maskadd - m_run + sl2v * (float)(4 * hi);
                    const float base3 = need1 ? base2 + sl2v * 64.f : -INFINITY;
                    f32x16 p0, p1, p2, p3;
#pragma unroll
                    for (int r = 0; r < 16; ++r) { const float c_ = sl2v * (float)((r & 3) + 8 * (r >> 2)), d_ = sl2v * (float)(32 + (r & 3) + 8 * (r >> 2));
                        p0[r] = base2 + c_; p1[r] = base2 + d_; p2[r] = base3 + c_; p3[r] = base3 + d_; }
#pragma unroll
                    for (int ks = 0; ks < 4; ++ks) { const int c = 2 * ks + hi; const LAS3 unsigned char* kp = lds3 + bo + kaddr + ((c ^ (r32 & 7)) * 16);
                        const h16x8 a0 = *(const LAS3 h16x8*)(kp), a1 = *(const LAS3 h16x8*)(kp + 4096), a2 = *(const LAS3 h16x8*)(kp + 8192), a3 = *(const LAS3 h16x8*)(kp + 8192 + 4096);
                        p0 = __builtin_amdgcn_mfma_f32_32x32x16_f16(a0, qf[ks], p0, 0, 0, 0); p1 = __builtin_amdgcn_mfma_f32_32x32x16_f16(a1, qf[ks], p1, 0, 0, 0);
                        p2 = __builtin_amdgcn_mfma_f32_32x32x16_f16(a2, qf[ks], p2, 0, 0, 0); p3 = __builtin_amdgcn_mfma_f32_32x32x16_f16(a3, qf[ks], p3, 0, 0, 0); }
                    if (t0 < 4) {
#pragma unroll
                        for (int r = 0; r < 16; ++r) { const int kv = t0 * 64 + (r & 3) + 8 * (r >> 2) + 4 * hi;
                            if (kv > qrel) p0[r] = -INFINITY; if (kv + 32 > qrel) p1[r] = -INFINITY; if (kv + 64 > qrel) p2[r] = -INFINITY; if (kv + 96 > qrel) p3[r] = -INFINITY; } }
                    float rm, rm2;
                    { rm = __builtin_fmaxf(__builtin_fmaxf(p0[0], p0[1]), p1[0]); rm2 = __builtin_fmaxf(__builtin_fmaxf(p2[0], p2[1]), p3[0]);
                      rm = __builtin_fmaxf(__builtin_fmaxf(rm, p1[1]), p0[2]); rm2 = __builtin_fmaxf(__builtin_fmaxf(rm2, p3[1]), p2[2]);
                      rm = __builtin_fmaxf(__builtin_fmaxf(rm, p0[3]), p1[2]); rm2 = __builtin_fmaxf(__builtin_fmaxf(rm2, p2[3]), p3[2]);
                      rm = __builtin_fmaxf(rm, p1[3]); rm2 = __builtin_fmaxf(rm2, p3[3]);
#pragma unroll
                      for (int r = 4; r < 16; r += 2) { rm = __builtin_fmaxf(__builtin_fmaxf(rm, p0[r]), p0[r + 1]); rm2 = __builtin_fmaxf(__builtin_fmaxf(rm2, p2[r]), p2[r + 1]);
                          rm = __builtin_fmaxf(__builtin_fmaxf(rm, p1[r]), p1[r + 1]); rm2 = __builtin_fmaxf(__builtin_fmaxf(rm2, p3[r]), p3[r + 1]); }
                      rm = __builtin_fmaxf(rm, rm2); }
                    rm = fmaxf(rm, __shfl_xor(rm, 32));
                    float dl = 0.f; bool resc = false;
                    if (tp == 0) { dl = rm; m_run = rm; }
                    else if (__any(rm > 8.f)) { dl = fmaxf(rm, 0.f); m_run += dl; resc = true; }
                    { typedef float f32x2p __attribute__((ext_vector_type(2))); const f32x2p dl2 = {dl, dl};
#define ATT_PKSUB(P) _Pragma("unroll") for (int r = 0; r < 16; r += 2) { f32x2p t_ = {P[r], P[r + 1]}; asm("v_pk_add_f32 %0, %0, %1 neg_lo:[0,1] neg_hi:[0,1]" : "+v"(t_) : "v"(dl2)); P[r] = t_[0]; P[r + 1] = t_[1]; }
                      ATT_PKSUB(p0) ATT_PKSUB(p1) ATT_PKSUB(p2) ATT_PKSUB(p3)
#undef ATT_PKSUB
                    }
                    if (resc) { const float f = __builtin_amdgcn_exp2f(-dl); l_run *= f; if (hi == 0) wsf[r32] = f;
#pragma unroll
                        for (int r = 0; r < 16; ++r) { const float fr_ = wsf[(r & 3) + 8 * (r >> 2) + 4 * hi]; o0[r] *= fr_; o1[r] *= fr_; } }
#pragma unroll
                    for (int r = 0; r < 16; ++r) { p0[r] = __builtin_amdgcn_exp2f(p0[r]); p1[r] = __builtin_amdgcn_exp2f(p1[r]); p2[r] = __builtin_amdgcn_exp2f(p2[r]); p3[r] = __builtin_amdgcn_exp2f(p3[r]); }
                    { const f32x16 t = (p0 + p1) + (p2 + p3);
                      typedef float f32x8s __attribute__((ext_vector_type(8))); typedef float f32x4s __attribute__((ext_vector_type(4))); typedef float f32x2s __attribute__((ext_vector_type(2)));
                      const f32x8s t8 = __builtin_shufflevector(t, t, 0, 1, 2, 3, 4, 5, 6, 7) + __builtin_shufflevector(t, t, 8, 9, 10, 11, 12, 13, 14, 15);
                      const f32x4s t4 = __builtin_shufflevector(t8, t8, 0, 1, 2, 3) + __builtin_shufflevector(t8, t8, 4, 5, 6, 7);
                      const f32x2s t2 = __builtin_shufflevector(t4, t4, 0, 1) + __builtin_shufflevector(t4, t4, 2, 3);
                      l_run += t2[0] + t2[1]; }
                    const h16x8 pa0 = pk8(p0, 0), pa1 = pk8(p0, 8), pa2 = pk8(p1, 0), pa3 = pk8(p1, 8), pa4 = pk8(p2, 0), pa5 = pk8(p2, 8), pa6 = pk8(p3, 0), pa7 = pk8(p3, 8);
                    const LAS3 unsigned char* vp = lds3 + bo + vaddr;
#define VFR_(off) ({ const h16x4 lo_ = tr16(vp + (off)), hh_ = tr16(vp + (off) + 512); (h16x8){lo_[0], lo_[1], lo_[2], lo_[3], hh_[0], hh_[1], hh_[2], hh_[3]}; })
                    o0 = __builtin_amdgcn_mfma_f32_32x32x16_f16(pa0, VFR_(0), o0, 0, 0, 0);           o1 = __builtin_amdgcn_mfma_f32_32x32x16_f16(pa0, VFR_(4096), o1, 0, 0, 0);
                    o0 = __builtin_amdgcn_mfma_f32_32x32x16_f16(pa1, VFR_(1024), o0, 0, 0, 0);        o1 = __builtin_amdgcn_mfma_f32_32x32x16_f16(pa1, VFR_(4096 + 1024), o1, 0, 0, 0);
                    o0 = __builtin_amdgcn_mfma_f32_32x32x16_f16(pa2, VFR_(2048), o0, 0, 0, 0);        o1 = __builtin_amdgcn_mfma_f32_32x32x16_f16(pa2, VFR_(4096 + 2048), o1, 0, 0, 0);
                    o0 = __builtin_amdgcn_mfma_f32_32x32x16_f16(pa3, VFR_(3072), o0, 0, 0, 0);        o1 = __builtin_amdgcn_mfma_f32_32x32x16_f16(pa3, VFR_(4096 + 3072), o1, 0, 0, 0);
                    o0 = __builtin_amdgcn_mfma_f32_32x32x16_f16(pa4, VFR_(8192), o0, 0, 0, 0);        o1 = __builtin_amdgcn_mfma_f32_32x32x16_f16(pa4, VFR_(8192 + 4096), o1, 0, 0, 0);
                    o0 = __builtin_amdgcn_mfma_f32_32x32x16_f16(pa5, VFR_(8192 + 1024), o0, 0, 0, 0); o1 = __builtin_amdgcn_mfma_f32_32x32x16_f16(pa5, VFR_(8192 + 4096 + 1024), o1, 0, 0, 0);
                    o0 = __builtin_amdgcn_mfma_f32_32x32x16_f16(pa6, VFR_(8192 + 2048), o0, 0, 0, 0); o1 = __builtin_amdgcn_mfma_f32_32x32x16_f16(pa6, VFR_(8192 + 4096 + 2048), o1, 0, 0, 0);
                    o0 = __builtin_amdgcn_mfma_f32_32x32x16_f16(pa7, VFR_(8192 + 3072), o0, 0, 0, 0); o1 = __builtin_amdgcn_mfma_f32_32x32x16_f16(pa7, VFR_(8192 + 4096 + 3072), o1, 0, 0, 0);
#undef VFR_
                }
                }
                st = (st == 2) ? 0 : st + 1;
            }
#undef ATT_KB
#undef ATT_GLDS
            { const float lt = l_run + __shfl_xor(l_run, 32); if (hi == 0) wsf[32 + r32] = lt;
              int hi_ = hi; asm volatile("" : "+v"(hi_));
              unsigned char* ot = lds + 100352 + wid * 4608;
#pragma unroll
              for (int r = 0; r < 16; ++r) { const int qr = (r & 3) + 8 * (r >> 2) + 4 * hi_; const float rl = __builtin_amdgcn_rcpf(wsf[32 + qr]);
                  *(h16*)(ot + qr * 144 + r32 * 2) = (h16)(o0[r] * rl); *(h16*)(ot + qr * 144 + 64 + r32 * 2) = (h16)(o1[r] * rl); }
              h16* Ow = MIX + (size_t)(b * S + own * 256 + wid * 32) * D + h * 64;
              typedef unsigned u32x4e __attribute__((ext_vector_type(4)));
#pragma unroll
              for (int i = 0; i < 4; ++i) { const int pc = lane + 64 * i, row = pc >> 3, q = pc & 7;
                  *(u32x4e*)(Ow + (size_t)row * D + q * 8) = *(const u32x4e*)(ot + row * 144 + q * 16); } }
        }
    }
    __builtin_amdgcn_s_setprio(0);
}
typedef __bf16 bf16x8 __attribute__((ext_vector_type(8)));
typedef __bf16 bf16x4 __attribute__((ext_vector_type(4)));
typedef float f32x4v __attribute__((ext_vector_type(4)));
__device__ __forceinline__ int offRM(int row, int col) { const int c = col >> 3; return c * 1024 + ((row ^ (c & 7)) << 4) + ((col & 7) << 1); }
__device__ __forceinline__ int offST(int v, int d) { const int c = d >> 3; return c * 2048 + ((v ^ (c & 7)) << 4) + ((d & 7) << 1); }
__device__ __forceinline__ int offSC(int t, int s) { const int c = s >> 3; return c * 1024 + ((t ^ c) << 4) + ((s & 7) << 1); }
__device__ __forceinline__ unsigned short bf16bits(float x) { const __bf16 h = (__bf16)x; return __builtin_bit_cast(unsigned short, h); }
__device__ __forceinline__ bf16x8 tr_frag(const LAS3 unsigned char* img, int k0, int n0, int lane) {
    const int li = lane & 15, q = li >> 2, pp = li & 3, ncol = n0 + 16 * ((lane >> 4) & 1) + 4 * pp, row = k0 + 8 * (lane >> 5) + q;
    const bf16x4 lo = __builtin_bit_cast(bf16x4, __builtin_amdgcn_ds_read_tr16_b64_v4i16((LAS3 v4i16_t*)(img + offRM(row, ncol))));
    const bf16x4 hh = __builtin_bit_cast(bf16x4, __builtin_amdgcn_ds_read_tr16_b64_v4i16((LAS3 v4i16_t*)(img + offRM(row + 4, ncol))));
    return (bf16x8){lo[0], lo[1], lo[2], lo[3], hh[0], hh[1], hh[2], hh[3]};
}
#define HG_BAR() do { asm volatile("s_waitcnt lgkmcnt(0)" ::: "memory"); __builtin_amdgcn_s_barrier(); asm volatile("" ::: "memory"); } while (0)
__device__ __forceinline__ void ph_hgrn(const P& p, unsigned char* lds) {
    const h16* PROJ = (const h16*)(p.ws + WS_PROJ); const float* LB = (const float*)(p.ws + WS_LB); h16* MIX = (h16*)(p.ws + WS_XN);
    constexpr int R0 = 0, QT = 32768, KT = 49152, QH = 65536, VV = 81920, SC = 98304, STo = 106496, TOT = 139264, EL = 141312, FD = 141824;
    const int tid0 = otid(), wid = __builtin_amdgcn_readfirstlane(tid0 >> 6);
    const LAS3 unsigned char* lds3 = (const LAS3 unsigned char*)lds;
    for (int item = blockIdx.x; item < NB_ * RH; item += gridDim.x) {
        const int tid = tid0;
        const int b = item / RH, hd = item % RH;
        f32x16 S0, S1;
#pragma unroll
        for (int r = 0; r < 16; ++r) { S0[r] = 0.f; S1[r] = 0.f; }
        __syncthreads();
        for (int i = tid; i < 2048; i += NTHR) *(uint4*)(lds + STo + i * 16) = make_uint4(0u, 0u, 0u, 0u);
        const float lbv = LB[hd * 128 + (tid & 127)];
        const float4 ngv = *(const float4*)(p.rec_g + hd * 128 + (tid & 31) * 4);
        typedef unsigned u32x4h __attribute__((ext_vector_type(4)));
        u32x4h pfF[2], pfQ[2]; h16x8 pfV[2];
#pragma unroll
        for (int j = 0; j < 2; ++j) { const int i = tid + NTHR * j, row = i >> 4, c16 = i & 15; const h16* src = PROJ + ((size_t)b * S + row) * INC + hd * 128 + c16 * 8;
            pfF[j] = *(const u32x4h*)(src + C_FR); pfQ[j] = *(const u32x4h*)(src + C_QR); pfV[j] = *(const h16x8*)(src + C_IR); }
        const int laneh = tid0 & 63, r32h = laneh & 31, hih = laneh >> 5;
#pragma unroll 1
        for (int ck = 0; ck < S / 64; ++ck) {
            int tid = tid0; asm volatile("" : "+v"(tid));
            const int lane = tid & 63, r32 = lane & 31, hi = lane >> 5;
            const size_t tok0 = (size_t)b * S + ck * 64;
#pragma unroll
            for (int j = 0; j < 2; ++j) { const int i = tid + NTHR * j, row = i >> 4, c16 = i & 15;
                *(u32x4h*)(lds + R0 + row * 256 + c16 * 16) = pfF[j]; *(u32x4h*)(lds + R0 + 16384 + row * 256 + c16 * 16) = pfQ[j];
                bf16x8 vb;
#pragma unroll
                for (int e = 0; e < 8; ++e) vb[e] = (__bf16)(float)pfV[j][e];
                *(bf16x8*)(lds + VV + offRM(row, c16 * 8)) = vb; }
            if (ck + 1 < S / 64) {
#pragma unroll
                for (int j = 0; j < 2; ++j) { const int i = tid + NTHR * j, row = i >> 4, c16 = i & 15; const h16* src = PROJ + (tok0 + 64 + row) * INC + hd * 128 + c16 * 8;
                    pfF[j] = *(const u32x4h*)(src + C_FR); pfQ[j] = *(const u32x4h*)(src + C_QR); pfV[j] = *(const h16x8*)(src + C_IR); } }
            HG_BAR();
            unsigned gq0[4], gq1[4];
#pragma unroll
            for (int it = 0; it < 4; ++it) { const uint2 t_ = *(const uint2*)(PROJ + (tok0 + it * 16 + wid * 2 + hi) * INC + C_GR + hd * 128 + r32 * 4); gq0[it] = t_.x; gq1[it] = t_.y; }
            const int d = tid & 127, tq = tid >> 7;
            float cumv[16], kkv[16], qfv[16];
            { float run = 0.f;
#pragma unroll
              for (int j = 0; j < 16; ++j) { const int t = tq * 16 + j;
                  const float fp = (float)*(const h16*)(lds + R0 + t * 256 + d * 2), qv = (float)*(const h16*)(lds + R0 + 16384 + t * 256 + d * 2);
                  const float f = lbv + (1.f - lbv) * sigmoidf_(fp); run += __builtin_amdgcn_logf(f);        cumv[j] = run; kkv[j] = 1.f - f; qfv[j] = qv * sigmoidf_(qv); }
              ((float*)(lds + TOT))[tq * 128 + d] = run; }
            HG_BAR();
            { const float* tot = (const float*)(lds + TOT); const float t0 = tot[d], t1 = tot[128 + d], t2 = tot[256 + d], t3 = tot[384 + d];
              const float cmid = t0 + t1, last = cmid + t2 + t3; const float off = (tq == 0) ? 0.f : (tq == 1) ? t0 : (tq == 2) ? cmid : cmid + t2;
              const float emid = __builtin_amdgcn_exp2f(cmid);
              if (tq == 0) { ((float*)(lds + EL))[d] = __builtin_amdgcn_exp2f(last); ((float*)(lds + FD))[d] = __builtin_amdgcn_exp2f(last - cmid); }
#pragma unroll
              for (int j = 0; j < 16; ++j) { const int t = tq * 16 + j; const float cm = off + cumv[j] - cmid; const float eq = __builtin_amdgcn_exp2f(cm); const float qt = qfv[j] * eq;
                  const int o = offRM(t, d);
                  *(unsigned short*)(lds + QT + o) = bf16bits(qt); *(unsigned short*)(lds + QH + o) = bf16bits(qt * emid); *(unsigned short*)(lds + KT + o) = bf16bits(kkv[j] * __builtin_amdgcn_rcpf(eq)); } }
            HG_BAR();
            if (wid < 3) {
                const int tt = (wid >= 1), st = (wid == 2);
                f32x16 acc;
#pragma unroll
                for (int r = 0; r < 16; ++r) acc[r] = 0.f;
#pragma unroll
                for (int kd = 0; kd < 8; ++kd) { const int cc = 2 * kd + hih;
                    const bf16x8 a = *(const LAS3 bf16x8*)(lds3 + QT + cc * 1024 + (((32 * tt + r32h) ^ (cc & 7)) << 4));
                    const bf16x8 bb = *(const LAS3 bf16x8*)(lds3 + KT + cc * 1024 + (((32 * st + r32h) ^ (cc & 7)) << 4));
                    acc = __builtin_amdgcn_mfma_f32_32x32x16_bf16(a, bb, acc, 0, 0, 0); }
#pragma unroll
                for (int r = 0; r < 16; ++r) { const int tr_ = (r & 3) + 8 * (r >> 2) + 4 * hih; float x = acc[r]; if (tt == st && r32h > tr_) x = 0.f;
                    *(unsigned short*)(lds + SC + offSC(32 * tt + tr_, 32 * st + r32h)) = bf16bits(x); }
            }
            HG_BAR();
            { const int th = wid >> 2, vt = wid & 3;
              f32x16 acc;
#pragma unroll
              for (int r = 0; r < 16; ++r) acc[r] = 0.f;
#pragma unroll
              for (int ks = 0; ks < 4; ++ks) { if (ks < 2 || th == 1) { const int cs = 2 * ks + hih;
                  const bf16x8 a = *(const LAS3 bf16x8*)(lds3 + SC + cs * 1024 + (((32 * th + r32h) ^ cs) << 4));
                  const bf16x8 bb = tr_frag(lds3 + VV, 16 * ks, 32 * vt, laneh);
                  acc = __builtin_amdgcn_mfma_f32_32x32x16_bf16(a, bb, acc, 0, 0, 0); } }
#pragma unroll
              for (int kd = 0; kd < 8; ++kd) { const int cc = 2 * kd + hih;
                  const bf16x8 a = *(const LAS3 bf16x8*)(lds3 + QH + cc * 1024 + (((32 * th + r32h) ^ (cc & 7)) << 4));
                  const bf16x8 bb = *(const LAS3 bf16x8*)(lds3 + STo + cc * 2048 + (((32 * vt + r32h) ^ (cc & 7)) << 4));
                  acc = __builtin_amdgcn_mfma_f32_32x32x16_bf16(a, bb, acc, 0, 0, 0); }
#pragma unroll
              for (int r = 0; r < 16; ++r) ((float*)(lds + R0))[(32 * th + (r & 3) + 8 * (r >> 2) + 4 * hih) * 128 + 32 * vt + r32h] = acc[r]; }
            HG_BAR();
            { const int dt = wid >> 1;
#pragma unroll
              for (int vi = 0; vi < 2; ++vi) { const int vt = 2 * (wid & 1) + vi;
                  f32x16 acc;
#pragma unroll
                  for (int r = 0; r < 16; ++r) acc[r] = 0.f;
#pragma unroll
                  for (int ks = 0; ks < 4; ++ks) { const bf16x8 a = tr_frag(lds3 + KT, 16 * ks, 32 * dt, laneh); const bf16x8 bb = tr_frag(lds3 + VV, 16 * ks, 32 * vt, laneh);
                      acc = __builtin_amdgcn_mfma_f32_32x32x16_bf16(a, bb, acc, 0, 0, 0); }
#pragma unroll
                  for (int g = 0; g < 4; ++g) { const int d0 = 32 * dt + 8 * g + 4 * hih; f32x4v nv;
#pragma unroll
                      for (int e = 0; e < 4; ++e) { const float el = ((const float*)(lds + EL))[d0 + e], fd = ((const float*)(lds + FD))[d0 + e];
                          const float sv = el * (vi == 0 ? S0[4 * g + e] : S1[4 * g + e]) + fd * acc[4 * g + e]; if (vi == 0) S0[4 * g + e] = sv; else S1[4 * g + e] = sv; nv[e] = sv; }
                      *(bf16x4*)(lds + STo + offST(32 * vt + r32h, d0)) = __builtin_convertvector(nv, bf16x4); } } }
#pragma unroll
            for (int it = 0; it < 4; ++it) { const int t = it * 16 + wid * 2 + hi; const float4 x = *(const float4*)(lds + R0 + t * 512 + r32 * 16);
                float ss = x.x * x.x + x.y * x.y + x.z * x.z + x.w * x.w;
                ss += dppmov<0xB1>(ss); ss += dppmov<0x4E>(ss); ss += dppmov<0x141>(ss); ss += dppmov<0x140>(ss); { float a_ = ss, b_ = ss; swap16(a_, b_); ss = a_ + b_; }
                const float rs = rsqrtf(ss * (1.f / 128.f) + EPS);
                const float4 ng = ngv;
                const h16x2 ga = __builtin_bit_cast(h16x2, gq0[it]), gb = __builtin_bit_cast(h16x2, gq1[it]);
                const float g0 = (float)ga[0], g1 = (float)ga[1], g2 = (float)gb[0], g3 = (float)gb[1];
                uint2 w; w.x = pkh(x.x * rs * ng.x * g0 * sigmoidf_(g0), x.y * rs * ng.y * g1 * sigmoidf_(g1)); w.y = pkh(x.z * rs * ng.z * g2 * sigmoidf_(g2), x.w * rs * ng.w * g3 * sigmoidf_(g3));
                *(uint2*)(MIX + (tok0 + t) * D + 512 + hd * 128 + r32 * 4) = w; }
            HG_BAR();
        }
    }
}
struct XInfo { int rank, nloc, vx, nx; };
__device__ __forceinline__ XInfo xinfo_get(const XcdBarrier& xb) {
    volatile LAS unsigned* st = xb.st;
    __syncthreads();
    if (threadIdx.x == 0) { unsigned vx = 0; for (unsigned j = 0; j < 16; ++j) { const unsigned c = xb_ld(&xb.bar[XB_XCNT(j)]); if (j < xb.x && c > 0u) ++vx; } st[3] = vx; }
    __syncthreads();
    XInfo xi; xi.nloc = (int)st[0]; xi.nx = (int)st[1]; xi.rank = (int)st[2]; xi.vx = (int)st[3];
    if (xi.nloc < 1) xi.nloc = 1;
    if (xi.nx < 1) xi.nx = 1;
    return xi;
}
typedef unsigned u32x4g __attribute__((ext_vector_type(4)));
constexpr size_t WS_PART = WS_PROJ;
constexpr size_t WS_SSQ = 608 * MiB;
template <int CTRL> __device__ __forceinline__ int dppmovi(int v) { return __builtin_amdgcn_mov_dpp(v, CTRL, 0xf, 0xf, true); }
__device__ __forceinline__ void ph_g1(const P& p, const XInfo xi) {
    const unsigned char* HN8 = p.ws + WS_HN; const unsigned char* U8 = p.ws + WS_U; const unsigned* SEL = (const unsigned*)(p.ws + WS_SELI); h16* PART = (h16*)(p.ws + WS_PART);
    const int tid = otid(), lane = tid & 63, wid = __builtin_amdgcn_readfirstlane(tid >> 6), rg = lane >> 3, seg = lane & 7;
    const int widx = xi.rank * NWAVE + wid, nwx = xi.nloc * NWAVE;
    for (int w = xi.vx; w < 8; w += xi.nx) { const int c = w & 3, hf = w >> 2;
        const unsigned char* Uc = U8 + (size_t)c * (16384 * 128);
        const unsigned sego = (unsigned)seg * 16u;
        u32x4g sl[4], uA[16], uB[16], xA0, xA1, xB0, xB1;
#define G1_TOK(I) (2 * (I) + hf)
#define G1_SEL(I) do { const u32x4g* sp_ = (const u32x4g*)(SEL + (size_t)G1_TOK(I) * 128 + rg * 16); sl[0] = sp_[0]; sl[1] = sp_[1]; sl[2] = sp_[2]; sl[3] = sp_[3]; } while (0)
#define G1_ROWS(UU, X0, X1, I) do { _Pragma("unroll") for (int g = 0; g < 16; ++g) UU[g] = *(const u32x4g*)(Uc + (size_t)(unsigned)(((sl[g >> 2][g & 3] >> 16) << 7) + sego)); \
            { const u32x4g* xp_ = (const u32x4g*)(HN8 + (size_t)G1_TOK(I) * D + c * 256 + seg * 32); X0 = xp_[0]; X1 = xp_[1]; } } while (0)
#define G1_DIG(P0, P1, HI, LO) do { const unsigned t0_ = (((P0) & 0x7f7f7f7fu) + 0x08080808u) ^ (((P0) & 0x80808080u) | 0x08080808u), t1_ = (((P1) & 0x7f7f7f7fu) + 0x08080808u) ^ (((P1) & 0x80808080u) | 0x08080808u); \
            HI = ((t0_ >> 4) & 0x0f0f0f0fu) | (t1_ & 0xf0f0f0f0u); LO = (t0_ & 0x0f0f0f0fu) | ((t1_ << 4) & 0xf0f0f0f0u); } while (0)
#define G1_COMP(UU, X0, X1, I) do { float dp[16]; unsigned xh_[4], xl_[4]; \
            { unsigned q0_ = X0[0], q1_ = X0[1], q2_ = X0[2], q3_ = X0[3], q4_ = X1[0], q5_ = X1[1], q6_ = X1[2], q7_ = X1[3]; \
              asm volatile("" : "+v"(q0_), "+v"(q1_), "+v"(q2_), "+v"(q3_), "+v"(q4_), "+v"(q5_), "+v"(q6_), "+v"(q7_));        \
              G1_DIG(q0_, q1_, xh_[0], xl_[0]); G1_DIG(q2_, q3_, xh_[1], xl_[1]); G1_DIG(q4_, q5_, xh_[2], xl_[2]); G1_DIG(q6_, q7_, xh_[3], xl_[3]); } \
            _Pragma("unroll") for (int g = 0; g < 16; ++g) { int a = 0; const u32x4g uw = UU[g]; \
                int al_ = 0; \
                _Pragma("unroll") for (int i = 0; i < 4; ++i) { a = __builtin_amdgcn_sdot8((int)xh_[i], (int)uw[i], a, false); al_ = __builtin_amdgcn_sdot8((int)xl_[i], (int)uw[i], al_, false); } \
                a = (a << 4) + al_; \
                a += dppmovi<0xB1>(a); a += dppmovi<0x4E>(a); a += dppmovi<0x141>(a); dp[g] = (float)a * (1.f / 2304.f); } \
            if (seg == 0) { u32x4g w0, w1; w0[0] = pkh(dp[0], dp[1]); w0[1] = pkh(dp[2], dp[3]); w0[2] = pkh(dp[4], dp[5]); w0[3] = pkh(dp[6], dp[7]); \
                w1[0] = pkh(dp[8], dp[9]); w1[1] = pkh(dp[10], dp[11]); w1[2] = pkh(dp[12], dp[13]); w1[3] = pkh(dp[14], dp[15]); \
                u32x4g* dst_ = (u32x4g*)(PART + ((size_t)c * T + G1_TOK(I)) * 128 + rg * 16); dst_[0] = w0; dst_[1] = w1; } } while (0)
        constexpr int TH = T / 2;
        int t = widx;
        if (t < TH) { G1_SEL(t); G1_ROWS(uA, xA0, xA1, t); if (t + nwx < TH) G1_SEL(t + nwx); }
#pragma unroll 1
        for (; t < TH; t += 2 * nwx) {
            const int t1 = t + nwx, t2 = t + 2 * nwx, t3 = t + 3 * nwx;
            if (t1 < TH) { G1_ROWS(uB, xB0, xB1, t1); if (t2 < TH) G1_SEL(t2); }
            G1_COMP(uA, xA0, xA1, t);
            if (t1 < TH) {
                if (t2 < TH) { G1_ROWS(uA, xA0, xA1, t2); if (t3 < TH) G1_SEL(t3); }
                G1_COMP(uB, xB0, xB1, t1);
            }
        }
#undef G1_TOK
#undef G1_SEL
#undef G1_ROWS
#undef G1_COMP
#undef G1_DIG
    }
}
constexpr size_t WS_WQ8 = 608 * MiB + 4 * MiB;
__device__ __forceinline__ float wave_max_fast(float s) {
    s = fmaxf(s, dppmov<0xB1>(s)); s = fmaxf(s, dppmov<0x4E>(s)); s = fmaxf(s, dppmov<0x141>(s)); s = fmaxf(s, dppmov<0x140>(s));
    { float a = s, b = s; swap16(a, b); s = fmaxf(a, b); }
    { float a = s, b = s; swap32(a, b); s = fmaxf(a, b); }
    return s;
}
__device__ __forceinline__ void ph_g2(const P& p) {
    const h16* PART = (const h16*)(p.ws + WS_PART); unsigned* SEL = (unsigned*)(p.ws + WS_SELI); float* WQ = (float*)(p.ws + WS_WQ8); const float* SS = (const float*)(p.ws + WS_SS);
    const int lane = otid() & 63; const int gw = (blockIdx.x * blockDim.x + otid()) >> 6, nw = (gridDim.x * blockDim.x) >> 6;
    for (int t0 = gw; t0 < T; t0 += 2 * nw) {
        unsigned praw[2][4]; uint2 wsel[2]; float ssv[2];
#pragma unroll
        for (int u = 0; u < 2; ++u) { const int t = t0 + u * nw; if (t < T) {
#pragma unroll
            for (int c = 0; c < 4; ++c) praw[u][c] = *(const unsigned*)(PART + ((size_t)c * T + t) * 128 + lane * 2);
            wsel[u] = *(const uint2*)(SEL + (size_t)t * 128 + lane * 2); ssv[u] = SS[t]; } }
#pragma unroll
        for (int u = 0; u < 2; ++u) { const int t = t0 + u * nw; if (t < T) {
            float s0 = 0.f, s1 = 0.f;
#pragma unroll
            for (int c = 0; c < 4; ++c) { const h16x2 v = __builtin_bit_cast(h16x2, praw[u][c]); s0 += (float)v[0]; s1 += (float)v[1]; }
            { const float rt = rsqrtf(ssv[u] * (1.f / D) + EPS); s0 *= rt; s1 *= rt; }
            uint2 w = wsel[u];
            const float a0 = 0.5f * s0 * (1.f + erff(s0 * 0.70710678118654752f)), a1 = 0.5f * s1 * (1.f + erff(s1 * 0.70710678118654752f));
            const float w0 = (float)__builtin_bit_cast(h16, (unsigned short)(w.x & 0xffffu)) * a0, w1 = (float)__builtin_bit_cast(h16, (unsigned short)(w.y & 0xffffu)) * a1;
            const float mx = fmaxf(wave_max_fast(fmaxf(fabsf(w0), fabsf(w1))), 1e-30f); const float sc = 127.f / mx;
            w.x = (w.x & 0xffff0000u) | q8(w0 * sc); w.y = (w.y & 0xffff0000u) | q8(w1 * sc);
            *(uint2*)(SEL + (size_t)t * 128 + lane * 2) = w;
            if (lane == 0) WQ[t] = mx * (1.f / 127.f); } }
    }
}
__device__ __forceinline__ void swap32i(int& a, int& b) { auto r = __builtin_amdgcn_permlane32_swap((unsigned)a, (unsigned)b, false, false); unsigned r0 = r[0], r1 = r[1]; asm volatile("" : "+v"(r0), "+v"(r1)); a = (int)r0; b = (int)r1; }
__device__ __forceinline__ void swap16i(int& a, int& b) { auto r = __builtin_amdgcn_permlane16_swap((unsigned)a, (unsigned)b, false, false); unsigned r0 = r[0], r1 = r[1]; asm volatile("" : "+v"(r0), "+v"(r1)); a = (int)r0; b = (int)r1; }
__device__ __forceinline__ void ph_g3(const P& p, const XInfo xi) {
    const unsigned char* V8 = p.ws + WS_V; const unsigned* SEL = (const unsigned*)(p.ws + WS_SELI); h16* AC = (h16*)(p.ws + WS_XN); const float* WQ = (const float*)(p.ws + WS_WQ8);
    const int tid = otid(), lane = tid & 63, wid = __builtin_amdgcn_readfirstlane(tid >> 6), rg = lane >> 3, seg = lane & 7;
    const int widx = xi.rank * NWAVE + wid, nwx = xi.nloc * NWAVE;
    for (int w = xi.vx; w < 8; w += xi.nx) { const int c = w & 3, hf = w >> 2;
        const unsigned char* Vc = V8 + (size_t)c * (16384 * 128);
        const unsigned sego = (unsigned)seg * 16u;
        u32x4g sl[4], vA[16], vB[16]; unsigned wpA[4], wpB[4]; float dA, dB; uint2 hA, hB;
        const h16* H16 = (const h16*)(p.ws + WS_H16);
#define G3_TOK(I) (2 * (I) + hf)
#define G3_SEL(I) do { const u32x4g* sp_ = (const u32x4g*)(SEL + (size_t)G3_TOK(I) * 128 + rg * 16); sl[0] = sp_[0]; sl[1] = sp_[1]; sl[2] = sp_[2]; sl[3] = sp_[3]; } while (0)
#define G3_ROWS(VV_, WP, DQ, HH, I) do { DQ = WQ[G3_TOK(I)]; HH = *(const uint2*)(H16 + (size_t)G3_TOK(I) * D + c * 256 + seg * 32 + 4 * rg);  _Pragma("unroll") for (int q = 0; q < 4; ++q) { const unsigned p01 = __builtin_amdgcn_perm(sl[q][1], sl[q][0], 0x0c0c0400u), p23 = __builtin_amdgcn_perm(sl[q][3], sl[q][2], 0x04000c0cu); WP[q] = p01 | p23; } \
            _Pragma("unroll") for (int g = 0; g < 16; ++g) VV_[g] = *(const u32x4g*)(Vc + (size_t)(unsigned)(((sl[g >> 2][g & 3] >> 16) << 7) + sego)); } while (0)
#define G3_T4(R0, R1, R2, R3, K, B) do { \
            const unsigned a01l = __builtin_amdgcn_perm(R1, R0, 0x05010400u), a01h = __builtin_amdgcn_perm(R1, R0, 0x07030602u), a23l = __builtin_amdgcn_perm(R3, R2, 0x05010400u), a23h = __builtin_amdgcn_perm(R3, R2, 0x07030602u); \
            const unsigned t0_ = __builtin_amdgcn_perm(a23l, a01l, 0x05040100u), t1_ = __builtin_amdgcn_perm(a23l, a01l, 0x07060302u), t2_ = __builtin_amdgcn_perm(a23h, a01h, 0x05040100u), t3_ = __builtin_amdgcn_perm(a23h, a01h, 0x07060302u); \
            s1[B]     = __builtin_amdgcn_sdot4((int)t0_, (int)WP_[K], s1[B], false);     s2[B]     = __builtin_amdgcn_sdot4((int)(t0_ & 0xf0f0f0f0u), (int)WP_[K], s2[B], false); \
            s1[B + 1] = __builtin_amdgcn_sdot4((int)t1_, (int)WP_[K], s1[B + 1], false); s2[B + 1] = __builtin_amdgcn_sdot4((int)(t1_ & 0xf0f0f0f0u), (int)WP_[K], s2[B + 1], false); \
            s1[B + 2] = __builtin_amdgcn_sdot4((int)t2_, (int)WP_[K], s1[B + 2], false); s2[B + 2] = __builtin_amdgcn_sdot4((int)(t2_ & 0xf0f0f0f0u), (int)WP_[K], s2[B + 2], false); \
            s1[B + 3] = __builtin_amdgcn_sdot4((int)t3_, (int)WP_[K], s1[B + 3], false); s2[B + 3] = __builtin_amdgcn_sdot4((int)(t3_ & 0xf0f0f0f0u), (int)WP_[K], s2[B + 3], false); } while (0)
#define G3_COMP(VV_, WP, DQ, HH, I) do { int s1[16], s2[16], acc[32]; const unsigned* WP_ = WP; \
            _Pragma("unroll") for (int i = 0; i < 16; ++i) { s1[i] = 0; s2[i] = 0; } \
            int wsum_ = 0; \
            _Pragma("unroll") for (int k = 0; k < 4; ++k) { wsum_ = __builtin_amdgcn_sdot4(0x01010101, (int)WP_[k], wsum_, false); \
                _Pragma("unroll") for (int i = 0; i < 4; ++i) G3_T4(VV_[4 * k][i], VV_[4 * k + 1][i], VV_[4 * k + 2][i], VV_[4 * k + 3][i], k, 4 * i); } \
            _Pragma("unroll") for (int i = 0; i < 4; ++i) _Pragma("unroll") for (int b = 0; b < 4; ++b) { acc[8 * i + b] = s1[4 * i + b] - s2[4 * i + b] - 8 * wsum_; acc[8 * i + 4 + b] = s2[4 * i + b] >> 4; } \
            int r16[16], r8[8], r4[4]; \
            _Pragma("unroll") for (int i = 0; i < 16; ++i) { int a = acc[i], b = acc[i + 16]; swap32i(a, b); r16[i] = a + b; } \
            _Pragma("unroll") for (int i = 0; i < 8; ++i) { int a = r16[i], b = r16[i + 8]; swap16i(a, b); r8[i] = a + b; } \
            const bool b3_ = (lane >> 3) & 1; \
            _Pragma("unroll") for (int i = 0; i < 4; ++i) { const int give = b3_ ? r8[i] : r8[i + 4], keep = b3_ ? r8[i + 4] : r8[i]; r4[i] = keep + dppmovi<0x128>(give); } \
            const float dq_ = DQ * (1.f / 32.f); \
            const h16x2 hx_ = __builtin_bit_cast(h16x2, HH.x), hy_ = __builtin_bit_cast(h16x2, HH.y); \
            uint2 ov_; ov_.x = pkh((float)hx_[0] + (float)r4[0] * dq_, (float)hx_[1] + (float)r4[1] * dq_); ov_.y = pkh((float)hy_[0] + (float)r4[2] * dq_, (float)hy_[1] + (float)r4[3] * dq_); \
            *(uint2*)(AC + (size_t)G3_TOK(I) * D + c * 256 + seg * 32 + 4 * rg) = ov_; } while (0)
        constexpr int TH = T / 2;
        int t = widx;
        if (t < TH) { G3_SEL(t); G3_ROWS(vA, wpA, dA, hA, t); if (t + nwx < TH) G3_SEL(t + nwx); }
#pragma unroll 1
        for (; t < TH; t += 2 * nwx) {
            const int t1 = t + nwx, t2 = t + 2 * nwx, t3 = t + 3 * nwx;
            if (t1 < TH) { G3_ROWS(vB, wpB, dB, hB, t1); if (t2 < TH) G3_SEL(t2); }
            G3_COMP(vA, wpA, dA, hA, t);
            if (t1 < TH) {
                if (t2 < TH) { G3_ROWS(vA, wpA, dA, hA, t2); if (t3 < TH) G3_SEL(t3); }
                G3_COMP(vB, wpB, dB, hB, t1);
            }
        }
#undef G3_TOK
#undef G3_SEL
#undef G3_ROWS
#undef G3_T4
#undef G3_COMP
    }
}
__device__ __forceinline__ void ph_g4(const P& p) {
    float* O = p.out; const h16* H16 = (const h16*)(p.ws + WS_H16); const float* gf = p.gf; const h16* AC = (const h16*)(p.ws + WS_XN);
    const int lane = otid() & 63; const int gw = (blockIdx.x * blockDim.x + otid()) >> 6, nw = (gridDim.x * blockDim.x) >> 6;
    float4 gg[4];
#pragma unroll
    for (int j = 0; j < 4; ++j) gg[j] = *(const float4*)(gf + (lane + 64 * j) * 4);
    for (int t0 = gw; t0 < T; t0 += 2 * nw) {
        uint2 araw[2][4];
#pragma unroll
        for (int u = 0; u < 2; ++u) { const int t = t0 + u * nw; if (t < T) {
#pragma unroll
            for (int j = 0; j < 4; ++j) araw[u][j] = *(const uint2*)(AC + (size_t)t * D + (lane + 64 * j) * 4); } }
#pragma unroll
        for (int u = 0; u < 2; ++u) { const int t = t0 + u * nw; if (t < T) {
            float4 o[4]; float ss = 0.f;
#pragma unroll
            for (int j = 0; j < 4; ++j) { const h16x2 a0 = __builtin_bit_cast(h16x2, araw[u][j].x), a1 = __builtin_bit_cast(h16x2, araw[u][j].y);
                o[j] = make_float4((float)a0[0], (float)a0[1], (float)a1[0], (float)a1[1]);
                ss += o[j].x * o[j].x + o[j].y * o[j].y + o[j].z * o[j].z + o[j].w * o[j].w; }
            const float r = rsqrtf(wave_sum_fast(ss) * (1.f / D) + EPS);
            float4* dst = (float4*)(O + (size_t)t * D);
#pragma unroll
            for (int j = 0; j < 4; ++j) dst[lane + 64 * j] = make_float4(o[j].x * r * gg[j].x, o[j].y * r * gg[j].y, o[j].z * r * gg[j].z, o[j].w * r * gg[j].w); } }
    }
}

__device__ __forceinline__ float vmax_(float a, float b) { float r; asm("v_max_f32_e32 %0, %1, %2" : "=v"(r) : "v"(a), "v"(b)); return r; }
__device__ __forceinline__ float vmin_(float a, float b) { float r; asm("v_min_f32_e32 %0, %1, %2" : "=v"(r) : "v"(a), "v"(b)); return r; }
__device__ __forceinline__ void ce_(float& a, float& b) { const float hi_ = vmax_(a, b), lo_ = vmin_(a, b); a = hi_; b = lo_; }
__device__ __forceinline__ void sort16(float (&v)[16]) {
#pragma unroll
    for (int p = 1; p < 16; p <<= 1)
#pragma unroll
        for (int k = p; k >= 1; k >>= 1)
#pragma unroll
            for (int j = k % p; j + k < 16; j += 2 * k)
#pragma unroll
                for (int i = 0; i < k; ++i)
                    if (i + j + k < 16 && (i + j) / (2 * p) == (i + j + k) / (2 * p)) ce_(v[i + j], v[i + j + k]);
}
__device__ __forceinline__ void merge_prune16(float (&a)[16], const float (&b)[16]) {
#pragma unroll
    for (int i = 0; i < 16; ++i) a[i] = vmax_(a[i], b[15 - i]);
#pragma unroll
    for (int s = 8; s >= 1; s >>= 1)
#pragma unroll
        for (int i = 0; i < 16; ++i) if ((i & s) == 0) ce_(a[i], a[i + s]);
}
__device__ __forceinline__ float mkc(float s, unsigned code) { return __builtin_bit_cast(float, (__builtin_bit_cast(unsigned, s) & ~255u) | code); }
__device__ __forceinline__ void ph_topk(const P& p, unsigned char* lds) {
    const h16* SC = (const h16*)(p.ws + WS_QP); unsigned* SEL = (unsigned*)(p.ws + WS_SELI);
    const int tid = otid(), lane = tid & 63, wid = __builtin_amdgcn_readfirstlane(tid >> 6), r32 = lane & 31, hi = lane >> 5;
    unsigned* scr = (unsigned*)(lds + wid * 4096);
    for (int tg = blockIdx.x; tg < T / 256; tg += gridDim.x) {
        const int tok = tg * 256 + wid * 32 + r32;
#pragma unroll 1
        for (int h = 0; h < PH; ++h) {
            float v1[16], v2[16];
#pragma unroll
            for (int c = 0; c < 2; ++c) {
                const h16x8* sp = (const h16x8*)(SC + (size_t)tok * QW + h * 256 + c * 128 + hi * 64);
                h16x8 raw[8];
#pragma unroll
                for (int q = 0; q < 8; ++q) raw[q] = sp[q];
                float g0[16], g1[16], g2[16], g3[16];
#pragma unroll
                for (int q = 0; q < 2; ++q)
#pragma unroll
                    for (int e = 0; e < 8; ++e) { const unsigned n = (unsigned)(hi * 64 + q * 8 + e);
                        g0[q * 8 + e] = __builtin_bit_cast(float, __builtin_bit_cast(unsigned, (float)raw[q][e]) | n);
                        g1[q * 8 + e] = __builtin_bit_cast(float, __builtin_bit_cast(unsigned, (float)raw[2 + q][e]) | (n + 16u));
                        g2[q * 8 + e] = __builtin_bit_cast(float, __builtin_bit_cast(unsigned, (float)raw[4 + q][e]) | (n + 32u));
                        g3[q * 8 + e] = __builtin_bit_cast(float, __builtin_bit_cast(unsigned, (float)raw[6 + q][e]) | (n + 48u)); }
                sort16(g0); sort16(g1); sort16(g2); sort16(g3);
                merge_prune16(g0, g1); merge_prune16(g2, g3); merge_prune16(g0, g2);
                float pr[16];
#pragma unroll
                for (int i = 0; i < 16; ++i) pr[i] = __shfl_xor(g0[i], 32);
                merge_prune16(g0, pr);
#pragma unroll
                for (int i = 0; i < 16; ++i) { if (c == 0) v1[i] = g0[i]; else v2[i] = g0[i]; }
            }
            if (hi == 0) {
#pragma unroll
                for (int i = 0; i < 16; ++i) { scr[i * 32 + r32] = __builtin_bit_cast(unsigned, v1[i]); scr[(16 + i) * 32 + r32] = __builtin_bit_cast(unsigned, v2[i]); } }
            float q0[16], q1[16], q2[16];
            q0[0] = mkc(v1[0] + v2[0], 0x00u);
            q0[1] = mkc(v1[0] + v2[1], 0x01u);
            q0[2] = mkc(v1[0] + v2[2], 0x02u);
            q0[3] = mkc(v1[0] + v2[3], 0x03u);
            q0[4] = mkc(v1[0] + v2[4], 0x04u);
            q0[5] = mkc(v1[0] + v2[5], 0x05u);
            q0[6] = mkc(v1[0] + v2[6], 0x06u);
            q0[7] = mkc(v1[0] + v2[7], 0x07u);
            q0[8] = mkc(v1[0] + v2[8], 0x08u);
            q0[9] = mkc(v1[0] + v2[9], 0x09u);
            q0[10] = mkc(v1[0] + v2[10], 0x0au);
            q0[11] = mkc(v1[0] + v2[11], 0x0bu);
            q0[12] = mkc(v1[0] + v2[12], 0x0cu);
            q0[13] = mkc(v1[0] + v2[13], 0x0du);
            q0[14] = mkc(v1[0] + v2[14], 0x0eu);
            q0[15] = mkc(v1[1] + v2[0], 0x10u);
            q1[0] = mkc(v1[1] + v2[1], 0x11u);
            q1[1] = mkc(v1[1] + v2[2], 0x12u);
            q1[2] = mkc(v1[1] + v2[3], 0x13u);
            q1[3] = mkc(v1[1] + v2[4], 0x14u);
            q1[4] = mkc(v1[1] + v2[5], 0x15u);
            q1[5] = mkc(v1[1] + v2[6], 0x16u);
            q1[6] = mkc(v1[1] + v2[7], 0x17u);
            q1[7] = mkc(v1[2] + v2[0], 0x20u);
            q1[8] = mkc(v1[2] + v2[1], 0x21u);
            q1[9] = mkc(v1[2] + v2[2], 0x22u);
            q1[10] = mkc(v1[2] + v2[3], 0x23u);
            q1[11] = mkc(v1[2] + v2[4], 0x24u);
            q1[12] = mkc(v1[3] + v2[0], 0x30u);
            q1[13] = mkc(v1[3] + v2[1], 0x31u);
            q1[14] = mkc(v1[3] + v2[2], 0x32u);
            q1[15] = mkc(v1[3] + v2[3], 0x33u);
            q2[0] = mkc(v1[4] + v2[0], 0x40u);
            q2[1] = mkc(v1[4] + v2[1], 0x41u);
            q2[2] = mkc(v1[4] + v2[2], 0x42u);
            q2[3] = mkc(v1[5] + v2[0], 0x50u);
            q2[4] = mkc(v1[5] + v2[1], 0x51u);
            q2[5] = mkc(v1[6] + v2[0], 0x60u);
            q2[6] = mkc(v1[6] + v2[1], 0x61u);
            q2[7] = mkc(v1[7] + v2[0], 0x70u);
            q2[8] = mkc(v1[7] + v2[1], 0x71u);
            q2[9] = mkc(v1[8] + v2[0], 0x80u);
            q2[10] = mkc(v1[9] + v2[0], 0x90u);
            q2[11] = mkc(v1[10] + v2[0], 0xa0u);
            q2[12] = mkc(v1[11] + v2[0], 0xb0u);
            q2[13] = mkc(v1[12] + v2[0], 0xc0u);
            q2[14] = mkc(v1[13] + v2[0], 0xd0u);
            q2[15] = mkc(v1[14] + v2[0], 0xe0u);
            const float x1 = mkc(v1[15] + v2[0], 0xf0u), x2 = mkc(v1[0] + v2[15], 0x0fu);
            sort16(q0); sort16(q1); sort16(q2);
            merge_prune16(q0, q1); merge_prune16(q0, q2);
            q0[15] = vmax_(q0[15], x1); ce_(q0[14], q0[15]); q0[15] = vmax_(q0[15], x2);
            const float smax = v1[0] + v2[0];
            const unsigned hmask = 0u - (unsigned)hi;
            float ex[8]; unsigned eidx[8]; float psum = 0.f;
#pragma unroll
            for (int i = 0; i < 8; ++i) { const float mine = __builtin_bit_cast(float, (__builtin_bit_cast(unsigned, q0[i]) & ~hmask) | (__builtin_bit_cast(unsigned, q0[8 + i]) & hmask)); const unsigned code = __builtin_bit_cast(unsigned, mine) & 255u;
                const unsigned n1 = scr[(code >> 4) * 32 + r32] & 127u, n2 = scr[(16 + (code & 15u)) * 32 + r32] & 127u;
                eidx[i] = n1 * 128u + n2; ex[i] = __builtin_amdgcn_exp2f((mine - smax) * 1.4426950408889634f); psum += ex[i]; }
            const float inv = 1.f / (psum + __shfl_xor(psum, 32));
            unsigned wout[8];
#pragma unroll
            for (int i = 0; i < 8; ++i) { const h16 gh = (h16)(ex[i] * inv); wout[i] = (eidx[i] << 16) | (unsigned)__builtin_bit_cast(unsigned short, gh); }
            uint4* dst = (uint4*)(SEL + ((size_t)tok * PH + h) * 16 + hi * 8);
            dst[0] = make_uint4(wout[0], wout[1], wout[2], wout[3]); dst[1] = make_uint4(wout[4], wout[5], wout[6], wout[7]);
        }
    }
}
constexpr int LDS_BYTES = 147456;
__global__ void __launch_bounds__(NTHR, 2) mk_fwd(P p) {
    extern __shared__ __attribute__((aligned(16))) unsigned char lds[];
    cg::grid_group grid = cg::this_grid();
    PG8_LAS unsigned char* lds3 = (PG8_LAS unsigned char*)lds;
    volatile LAS unsigned* xst = (volatile LAS unsigned*)(lds3 + LDS_BYTES - 16);
    if (threadIdx.x < 4) xst[threadIdx.x] = 0u;
    __syncthreads();
    const XcdBarrier xb = xcd_barrier_post((unsigned*)p.ws, xst);
    ph_prep(p, lds);
    grid.sync();
    {
        pg8::Gemm g{(const pg8::bf16_t*)(p.ws + WS_HN8), (const pg8::bf16_t*)(p.ws + WS_WIN), T, INC, D / 2}; pg8::StaticOrder So; So.init(T, INC, gridDim.x, blockIdx.x);
        pg8::EpiProjI8 E{(pg8::bf16_t*)(p.ws + WS_PROJ), INC, (float*)(p.ws + WS_KM)};
        pg8::gemm_phase<pg8::EpiProjI8, pg8::StaticOrder, true, true>(lds3, g, So, E);
    }
    xcd_barrier(xb);
    ph_hgrn(p, lds);
    __syncthreads();
    ph_attn(p, lds);
    xcd_barrier(xb);
    {
        pg8::Gemm g{(const pg8::bf16_t*)(p.ws + WS_XN), (const pg8::bf16_t*)(p.ws + WS_WOUT), T, D, D}; pg8::StaticOrder So; So.init(T, D, gridDim.x, blockIdx.x);
        pg8::EpiOut E{p.x, (pg8::bf16_t*)(p.ws + WS_H16), D, p.g2, (pg8::bf16_t*)(p.ws + WS_HN), p.ws + WS_HN8, (float*)(p.ws + WS_SS)};
        pg8::gemm_phase<pg8::EpiOut, pg8::StaticOrder, true, true>(lds3, g, So, E);
    }
    xcd_barrier(xb);
    {
        pg8::Gemm g{(const pg8::bf16_t*)(p.ws + WS_HN), (const pg8::bf16_t*)(p.ws + WS_WQ), T, QW, D / 2}; pg8::StaticOrder So; So.init(T, QW, gridDim.x, blockIdx.x);
        pg8::EpiI8RS E{(pg8::bf16_t*)(p.ws + WS_QP), QW, (const float*)(p.ws + WS_SS)};
        pg8::gemm_phase<pg8::EpiI8RS, pg8::StaticOrder, true, true>(lds3, g, So, E);
    }
    xcd_barrier(xb);
    ph_topk(p, lds);
    xcd_barrier(xb);
    { const XInfo xi = xinfo_get(xb);
      ph_g1(p, xi);
      xcd_barrier(xb);
      ph_g2(p);
      xcd_barrier(xb);
      ph_g3(p, xi);
      xcd_barrier(xb);
      ph_g4(p); }
}

extern "C" void kernel_launch(void* const* d_in, const int* in_sizes, int n_in, void* d_out, int out_size, void* d_ws, size_t ws_size, hipStream_t stream) {
    static int grid = 0;
    if (grid == 0) {
        int dev = 0, cus = 0, per_cu = 0;
        (void)hipGetDevice(&dev); (void)hipDeviceGetAttribute(&cus, hipDeviceAttributeMultiprocessorCount, dev);
        (void)hipFuncSetAttribute((const void*)mk_fwd, hipFuncAttributeMaxDynamicSharedMemorySize, LDS_BYTES);
        (void)hipOccupancyMaxActiveBlocksPerMultiprocessor(&per_cu, (const void*)mk_fwd, NTHR, LDS_BYTES);
        if (per_cu < 1) { fprintf(stderr, "kernel_launch: occupancy query says %d blocks/CU\n", per_cu); per_cu = 1; }
        if (per_cu > 1) per_cu = 1;
        grid = cus * per_cu;
        if (ws_size < 928 * MiB) { fprintf(stderr, "kernel_launch: workspace too small (%zu)\n", ws_size); grid = -1; }
    }
    if (grid < 0) return;
    P p{};
    p.x = (const float*)d_in[0]; p.g1 = (const float*)d_in[1]; p.w_in = (const float*)d_in[2]; p.lb_logits = (const float*)d_in[3]; p.rec_g = (const float*)d_in[4];
    p.w_out = (const float*)d_in[5]; p.g2 = (const float*)d_in[6]; p.wq = (const float*)d_in[7]; p.subk = (const float*)d_in[8]; p.u = (const float*)d_in[9];
    p.v = (const float*)d_in[10]; p.gf = (const float*)d_in[11]; p.out = (float*)d_out; p.ws = (unsigned char*)d_ws;
    (void)hipMemsetAsync(d_ws, 0, 16384, stream);
    void* args[] = {&p};
    hipError_t e = hipLaunchCooperativeKernel((const void*)mk_fwd, dim3(grid), dim3(NTHR), args, LDS_BYTES, stream);
    if (e != hipSuccess) fprintf(stderr, "cooperative launch failed: %s (grid %d)\n", hipGetErrorString(e), grid);
}
```
